# Optimizing an MI355X kernel written in HIP

```python
import math
import jax
import jax.numpy as jnp
from jax import lax
import numpy as np


D_MODEL = 1024
BATCH = 32
SEQ = 2048
DEPTH = 4

HEAD_DIM = 64
LRU_WIDTH = D_MODEL // 4
ATTN_WIDTH = D_MODEL - LRU_WIDTH
N_ATTN_HEADS = ATTN_WIDTH // HEAD_DIM
DILATED_PATTERNS = ((128, 1), (512, 4), (2048, 16))
N_LRU_BLOCKS = 4
LRU_BLOCK = LRU_WIDTH // N_LRU_BLOCKS
CONV_WIDTH = 4
LRU_C = 8.0
IN_WIDTH = 3 * ATTN_WIDTH + 2 * LRU_WIDTH
N_EXPERTS = 32
TOP_K = 4
D_FF = D_MODEL
SWIGLU_LIMIT = 7.0
SWIGLU_ALPHA = 1.702
N_MOD = 6
DEEPNORM_ALPHA = (2.0 * DEPTH) ** 0.25
DEEPNORM_BETA = (8.0 * DEPTH) ** -0.25
LN_EPS = 1e-5
RMS_EPS = 1e-6
NEG_INF = -1e30

kernel_name = 'hybrid_dilated_attn_rglru_moe_deepnorm'


def alibi_slopes(n):
    def pow2_slopes(m):
        start = 2.0 ** (-8.0 / m)
        return [start ** (i + 1) for i in range(m)]
    p = 2 ** int(math.floor(math.log2(n)))
    s = pow2_slopes(p)
    if p < n:
        s = s + pow2_slopes(2 * p)[0::2][: n - p]
    return np.asarray(s, dtype=np.float32)


def layer_norm(x, g=None, b=None):
    xf = x.astype(jnp.float32)
    xc = xf - jnp.mean(xf, -1, keepdims=True)
    y = xc * lax.rsqrt(jnp.mean(xc * xc, -1, keepdims=True) + LN_EPS)
    if g is not None:
        y = y * g.astype(jnp.float32) + b.astype(jnp.float32)
    return y.astype(x.dtype)


def rms_norm(x, g):
    xf = x.astype(jnp.float32)
    y = xf * lax.rsqrt(jnp.mean(xf * xf, -1, keepdims=True) + RMS_EPS) * g.astype(jnp.float32)
    return y.astype(x.dtype)


def band_attention(q, k, v, slopes, window, dil):
    B, S, H, hd = q.shape
    L = S // dil
    W = window // dil
    nblk = -(-L // W)
    pad = nblk * W - L
    BD = B * dil

    def to_blocks(t):
        t = t.reshape(B, L, dil, H, hd).transpose(0, 2, 3, 1, 4).reshape(BD, H, L, hd)
        t = jnp.pad(t, ((0, 0), (0, 0), (0, pad), (0, 0)))
        return t.reshape(BD, H, nblk, W, hd)

    def with_prev(t):
        prev = jnp.pad(t, ((0, 0), (0, 0), (1, 0), (0, 0), (0, 0)))[:, :, :-1]
        return jnp.concatenate([prev, t], axis=3)

    qb = to_blocks(q)
    kk = with_prev(to_blocks(k))
    vv = with_prev(to_blocks(v))
    scores = jnp.einsum('bhnqd,bhnkd->bhnqk', qb, kk, preferred_element_type=jnp.float32) * (hd ** -0.5)
    rel = (W + jnp.arange(W))[:, None] - jnp.arange(2 * W)[None, :]
    not_front = (jnp.arange(nblk)[:, None, None] > 0) | (jnp.arange(2 * W)[None, None, :] >= W)
    mask = (rel >= 0)[None] & (rel <= W)[None] & not_front
    bias = -slopes[:, None, None] * (dil * rel).astype(jnp.float32)[None]
    scores = jnp.where(mask[None, None], scores + bias[None, :, None], NEG_INF)
    m = jnp.max(scores, -1, keepdims=True)
    p = jnp.exp(scores - m)
    s = jnp.sum(p, -1, keepdims=True)
    o = jnp.einsum('bhnqk,bhnkd->bhnqd', p, vv.astype(jnp.float32)) / s
    lse = (m + jnp.log(s))[..., 0]
    o = o.reshape(BD, H, nblk * W, hd)[:, :, :L]
    o = o.reshape(B, dil, H, L, hd).transpose(0, 3, 1, 2, 4).reshape(B, S, H, hd)
    lse = lse.reshape(BD, H, nblk * W)[:, :, :L]
    lse = lse.reshape(B, dil, H, L).transpose(0, 3, 1, 2).reshape(B, S, H)
    return o, lse


def dilated_attention(q, k, v, slopes):
    outs = []
    lses = []
    for window, dil in DILATED_PATTERNS:
        o, lse = band_attention(q, k, v, slopes, window, dil)
        outs.append(o)
        lses.append(lse)
    w = jax.nn.softmax(jnp.stack(lses, 0), axis=0)
    return jnp.einsum('pbsh,pbshd->bshd', w, jnp.stack(outs, 0))


def _lin_combine(e1, e2):
    return (e1[0] * e2[0], e2[0] * e1[1] + e2[1])


def rg_lru_branch(xr, xg, conv_w, conv_b, w_a, b_a, w_x, b_x, lam):
    B, S, R = xr.shape
    xc = lax.conv_general_dilated(xr, conv_w.astype(xr.dtype)[:, None, :], (1,), ((CONV_WIDTH - 1, 0),),
                                  dimension_numbers=('NWC', 'WIO', 'NWC'), feature_group_count=R) + conv_b
    xb = xc.reshape(B, S, N_LRU_BLOCKS, LRU_BLOCK)
    r = jax.nn.sigmoid((jnp.einsum('bsni,nij->bsnj', xb, w_a).reshape(B, S, R) + b_a).astype(jnp.float32))
    i = jax.nn.sigmoid((jnp.einsum('bsni,nij->bsnj', xb, w_x).reshape(B, S, R) + b_x).astype(jnp.float32))
    log_a = -LRU_C * r * jax.nn.softplus(-lam.astype(jnp.float32))
    a = jnp.exp(log_a)
    b = jnp.sqrt(-jnp.expm1(2.0 * log_a)) * i * xc.astype(jnp.float32)
    _, h = lax.associative_scan(_lin_combine, (a, b), axis=1)
    return (h * jax.nn.gelu(xg.astype(jnp.float32))).astype(xr.dtype)


def moe_ffn(u, router_w, router_b, w1, b1, w2, b2):
    B, S, D = u.shape
    t = u.reshape(B * S, D)
    logits = (t @ router_w).astype(jnp.float32) + router_b.astype(jnp.float32)
    vals, idx = lax.top_k(logits, TOP_K)
    wts = jax.nn.softmax(vals, axis=-1)
    gates = jnp.einsum('tk,tke->te', wts, jax.nn.one_hot(idx, N_EXPERTS, dtype=jnp.float32))
    out = jnp.zeros((B * S, D), jnp.float32)
    for e in range(N_EXPERTS):
        h = t @ w1[e] + b1[e]
        hg = jnp.minimum(h[:, :D_FF], SWIGLU_LIMIT)
        hu = jnp.clip(h[:, D_FF:], -SWIGLU_LIMIT, SWIGLU_LIMIT)
        act = hg * jax.nn.sigmoid(SWIGLU_ALPHA * hg) * (hu + 1.0)
        out = out + gates[:, e:e + 1] * (act @ w2[e] + b2[e]).astype(jnp.float32)
    return out.reshape(B, S, D).astype(u.dtype)


def setup_inputs(seed: int = 0) -> dict:
    key = jax.random.key(seed)
    ks = jax.random.split(key, 24)
    f32 = jnp.float32

    def nrm(k, shape, scale):
        return scale * jax.random.normal(k, shape, f32)

    col_scale = jnp.concatenate([jnp.ones((2 * ATTN_WIDTH,), f32),
                                 jnp.full((ATTN_WIDTH + LRU_WIDTH,), DEEPNORM_BETA, f32),
                                 jnp.ones((LRU_WIDTH,), f32)])
    u = jax.random.uniform(ks[10], (DEPTH, LRU_WIDTH), f32, 0.9, 0.999)
    a0 = u ** (1.0 / LRU_C)
    lam = jnp.log(a0) - jnp.log1p(-a0)
    return {
        'x': nrm(ks[0], (BATCH, SEQ, D_MODEL), 1.0),
        'c': nrm(ks[1], (BATCH, D_MODEL), 1.0),
        'w_cond': nrm(ks[2], (DEPTH, D_MODEL, N_MOD * D_MODEL), 0.2 * D_MODEL ** -0.5),
        'b_cond': nrm(ks[3], (DEPTH, N_MOD * D_MODEL), 0.01),
        'w_in': nrm(ks[4], (DEPTH, D_MODEL, IN_WIDTH), D_MODEL ** -0.5) * col_scale,
        'conv_w': nrm(ks[5], (DEPTH, CONV_WIDTH, LRU_WIDTH), CONV_WIDTH ** -0.5),
        'conv_b': nrm(ks[6], (DEPTH, LRU_WIDTH), 0.01),
        'lru_wa': nrm(ks[7], (DEPTH, N_LRU_BLOCKS, LRU_BLOCK, LRU_BLOCK), LRU_BLOCK ** -0.5),
        'lru_ba': nrm(ks[8], (DEPTH, LRU_WIDTH), 0.01),
        'lru_wx': nrm(ks[9], (DEPTH, N_LRU_BLOCKS, LRU_BLOCK, LRU_BLOCK), LRU_BLOCK ** -0.5),
        'lru_bx': nrm(ks[11], (DEPTH, LRU_WIDTH), 0.01),
        'lru_lambda': lam,
        'attn_norm_g': 1.0 + nrm(ks[12], (DEPTH, ATTN_WIDTH), 0.02),
        'lru_norm_g': 1.0 + nrm(ks[13], (DEPTH, LRU_WIDTH), 0.02),
        'w_out': nrm(ks[14], (DEPTH, D_MODEL, D_MODEL), DEEPNORM_BETA * D_MODEL ** -0.5),
        'ln1_g': 1.0 + nrm(ks[15], (DEPTH, D_MODEL), 0.02),
        'ln1_b': nrm(ks[16], (DEPTH, D_MODEL), 0.01),
        'router_w': nrm(ks[17], (DEPTH, D_MODEL, N_EXPERTS), D_MODEL ** -0.5),
        'router_b': nrm(ks[18], (DEPTH, N_EXPERTS), 0.01),
        'exp_w1': nrm(ks[19], (DEPTH, N_EXPERTS, D_MODEL, 2 * D_FF), DEEPNORM_BETA * D_MODEL ** -0.5),
        'exp_b1': nrm(ks[20], (DEPTH, N_EXPERTS, 2 * D_FF), 0.01),
        'exp_w2': nrm(ks[21], (DEPTH, N_EXPERTS, D_FF, D_MODEL), DEEPNORM_BETA * D_FF ** -0.5),
        'exp_b2': nrm(ks[22], (DEPTH, N_EXPERTS, D_MODEL), 0.01),
        'ln2_g': 1.0 + nrm(ks[23], (DEPTH, D_MODEL), 0.02),
        'ln2_b': nrm(ks[3], (DEPTH, D_MODEL), 0.01) + 0.001,
    }


def reference(x, c, w_cond, b_cond, w_in, conv_w, conv_b, lru_wa, lru_ba, lru_wx, lru_bx, lru_lambda,
              attn_norm_g, lru_norm_g, w_out, ln1_g, ln1_b, router_w, router_b,
              exp_w1, exp_b1, exp_w2, exp_b2, ln2_g, ln2_b):
    B, S, D = x.shape
    slopes = jnp.asarray(alibi_slopes(N_ATTN_HEADS))
    mods = jnp.einsum('bd,lde->lbe', jax.nn.silu(c), w_cond) + b_cond[:, None, :]
    splits = [ATTN_WIDTH, 2 * ATTN_WIDTH, 3 * ATTN_WIDTH, 3 * ATTN_WIDTH + LRU_WIDTH]
    for l in range(DEPTH):
        sh1, sc1, g1, sh2, sc2, g2 = jnp.split(mods[l][:, None, :], N_MOD, axis=-1)
        u = layer_norm(x) * (1.0 + sc1) + sh1
        q, k, v, xr, xg = jnp.split(u @ w_in[l], splits, axis=-1)
        attn = dilated_attention(q.reshape(B, S, N_ATTN_HEADS, HEAD_DIM),
                                 k.reshape(B, S, N_ATTN_HEADS, HEAD_DIM),
                                 v.reshape(B, S, N_ATTN_HEADS, HEAD_DIM), slopes)
        attn = attn.reshape(B, S, ATTN_WIDTH).astype(x.dtype)
        lru = rg_lru_branch(xr, xg, conv_w[l], conv_b[l], lru_wa[l], lru_ba[l], lru_wx[l], lru_bx[l], lru_lambda[l])
        mixed = jnp.concatenate([rms_norm(attn, attn_norm_g[l]), rms_norm(lru, lru_norm_g[l])], axis=-1) @ w_out[l]
        x = layer_norm(DEEPNORM_ALPHA * x + (1.0 + g1) * mixed, ln1_g[l], ln1_b[l])
        u2 = layer_norm(x) * (1.0 + sc2) + sh2
        ffn = moe_ffn(u2, router_w[l], router_b[l], exp_w1[l], exp_b1[l], exp_w2[l], exp_b2[l])
        x = layer_norm(DEEPNORM_ALPHA * x + (1.0 + g2) * ffn, ln2_g[l], ln2_b[l])
    return x
```

```cpp
#include <hip/hip_runtime.h>
#include <cstdio>
#include <cstdint>
namespace pg8 {
#define PG8_LAS __attribute__((address_space(3)))
typedef unsigned short bf16_t;
typedef short bf16x8 __attribute__((ext_vector_type(8)));
typedef float f32x4 __attribute__((ext_vector_type(4)));
typedef float f32x2 __attribute__((ext_vector_type(2)));
typedef unsigned u32x4 __attribute__((ext_vector_type(4)));
constexpr int BM = 256, BK = 64, HALF = 128, HTB = HALF * BK * 2, STAGE_BYTES = 8 * HTB, NXCD = 8, WGM = 8;
__host__ __device__ __forceinline__ int lds_byte(int r, int c) { const int st = (r >> 4) * 2 + (c >> 5), rr = r & 15, cc = c & 31, ob = rr * 64 + cc * 2; return st * 1024 + (ob ^ (((ob >> 9) & 1) << 5)); }
__host__ __device__ __forceinline__ void stage_rc(int b, int& R, int& C) { const int st = b / 1024, sb = b % 1024, swz = sb ^ (((sb >> 9) & 1) << 5); R = (st >> 1) * 16 + swz / 64; C = (st & 1) * 32 + (swz % 64) / 2; }
__host__ __device__ __forceinline__ int perm32(int rho) { const int n = rho >> 4, i = rho & 15; return 8 * (i >> 2) + 4 * n + (i & 3); }
struct Unit { int pm, pn, e; };
struct Gemm { const bf16_t* A; const bf16_t* Bt; int K; size_t bstride; };
struct TileOrder {
    int nM, nN, nwg, G, c; const PG8_LAS unsigned short* tile_e;
    __device__ void init(int nM_, int nN_, int G_, int c_, const PG8_LAS unsigned short* te) { nM = nM_; nN = nN_; nwg = nM * nN; G = G_; c = c_; tile_e = te; }
    __device__ bool next(int i, Unit& u) const {
        const long L = (long)i * G + c; if (L >= nwg) return false;
        int wgid = (int)L; { const int q = nwg / NXCD, r = nwg % NXCD, xcd = wgid % NXCD, off = wgid / NXCD; wgid = (xcd < r ? xcd * (q + 1) : r * (q + 1) + (xcd - r) * q) + off; }
        const int nig = WGM * nN, gid = wgid / nig, fm = gid * WGM, gsz = (nM - fm) < WGM ? (nM - fm) : WGM;
        u.pm = fm + ((wgid % nig) % gsz); u.pn = (wgid % nig) / gsz; u.e = tile_e ? (int)tile_e[u.pm] : 0; return true;
    }
    __device__ __forceinline__ void a_ready(const Unit&) const {}
    __device__ __forceinline__ void done(const Unit&) const {}
};
__device__ __forceinline__ unsigned cvt_pk_bf16(float lo, float hi) { unsigned r; asm volatile("v_cvt_pk_bf16_f32 %0, %1, %2" : "=v"(r) : "v"(lo), "v"(hi)); return r; }
struct EpiBf16 {
    static constexpr bool PERM = true, AFTER_DRAIN = false;
    bf16_t* O; int ldc; const float* bias; int bias_stride;
    __device__ __forceinline__ void operator()(const f32x4 (&acc)[2][2][4][2], const Unit& u, int wr, int wc, int fr, int fq) const {
        const int row0 = u.pm * BM + wr * 64 + fr; const int col0 = u.pn * BM + wc * 32 + 8 * fq;
        f32x4 bv[2][2];
#pragma unroll
        for (int bj = 0; bj < 2; ++bj)
#pragma unroll
            for (int n = 0; n < 2; ++n) bv[bj][n] = bias ? *(const f32x4*)(bias + (size_t)u.e * bias_stride + col0 + bj * HALF + 4 * n) : (f32x4){0.f, 0.f, 0.f, 0.f};
#pragma unroll
        for (int ai = 0; ai < 2; ++ai)
#pragma unroll
            for (int m = 0; m < 4; ++m) { bf16_t* rowp = O + (size_t)(row0 + ai * HALF + m * 16) * ldc + col0;
#pragma unroll
                for (int bj = 0; bj < 2; ++bj) { const f32x4 v0 = acc[ai][bj][m][0] + bv[bj][0], v1 = acc[ai][bj][m][1] + bv[bj][1];
                    u32x4 w; w.x = cvt_pk_bf16(v0[0], v0[1]); w.y = cvt_pk_bf16(v0[2], v0[3]); w.z = cvt_pk_bf16(v1[0], v1[1]); w.w = cvt_pk_bf16(v1[2], v1[3]);
                    *(u32x4*)(rowp + bj * HALF) = w; } }
    }
};
__device__ __forceinline__ float swiglu1(float g, float u) {
    g = fminf(g, 7.0f); u = fminf(fmaxf(u, -7.0f), 7.0f);
    const float sg = __builtin_amdgcn_rcpf(1.0f + __builtin_amdgcn_exp2f(g * (-1.702f * 1.44269504f)));
    return g * sg * (u + 1.0f);
}
struct EpiSwiglu {
    static constexpr bool PERM = true, AFTER_DRAIN = false;
    bf16_t* O; const float* b1;
    __device__ __forceinline__ void operator()(const f32x4 (&acc)[2][2][4][2], const Unit& u, int wr, int wc, int fr, int fq) const {
        const int row0 = u.pm * BM + wr * 64 + fr; const int col0 = u.pn * HALF + wc * 32 + 8 * fq;
        const float* bg = b1 + (size_t)u.e * 2048 + col0;
        f32x4 bgv[2], buv[2];
#pragma unroll
        for (int n = 0; n < 2; ++n) { bgv[n] = *(const f32x4*)(bg + 4 * n); buv[n] = *(const f32x4*)(bg + 1024 + 4 * n); }
#pragma unroll
        for (int ai = 0; ai < 2; ++ai)
#pragma unroll
            for (int m = 0; m < 4; ++m) { bf16_t* rowp = O + (size_t)(row0 + ai * HALF + m * 16) * 1024 + col0;
                const f32x4 g0 = acc[ai][0][m][0] + bgv[0], g1 = acc[ai][0][m][1] + bgv[1], u0 = acc[ai][1][m][0] + buv[0], u1 = acc[ai][1][m][1] + buv[1];
                u32x4 w; w.x = cvt_pk_bf16(swiglu1(g0[0], u0[0]), swiglu1(g0[1], u0[1])); w.y = cvt_pk_bf16(swiglu1(g0[2], u0[2]), swiglu1(g0[3], u0[3]));
                w.z = cvt_pk_bf16(swiglu1(g1[0], u1[0]), swiglu1(g1[1], u1[1])); w.w = cvt_pk_bf16(swiglu1(g1[2], u1[2]), swiglu1(g1[3], u1[3]));
                *(u32x4*)rowp = w; }
    }
};
template <class Epi, class Sched, bool ALIGN_EPI = false, bool SP2 = false>
__device__ __forceinline__ void gemm_phase(PG8_LAS unsigned char* lds, const Gemm g, const Sched& S, const Epi& E, const int tid_in) {
    const int tid = tid_in, wid = __builtin_amdgcn_readfirstlane(tid >> 6), lane = tid & 63, wr = wid >> 2, wc = wid & 3, fr = lane & 15, fq = lane >> 4;
    const int K = g.K, nt = K / BK;
    unsigned voffA[2], voffB[2];
#pragma unroll
    for (int i = 0; i < 2; ++i) { int R, C; stage_rc(tid * 16 + i * 8192, R, C); const int Rb = Epi::PERM ? ((R & ~31) + perm32(R & 31)) : R;
        voffA[i] = (unsigned)(R * K + C) * 2u; voffB[i] = (unsigned)(Rb * K + C) * 2u; }
    const size_t kstep = (size_t)(BK * 2);
    const size_t hstep = (size_t)HALF * K * 2;
    const size_t tstep = 2 * hstep;
    const unsigned ldsw = (unsigned)wid * 1024u;
    const int aoff = lds_byte(wr * 64 + fr, fq * 8), boff = lds_byte(wc * 32 + fr, fq * 8);
#define PG8_SA(b, h) (((b) * 2 + (h)) * HTB)
#define PG8_SB(b, h) ((4 + (b) * 2 + (h)) * HTB)
#define PG8_STAGE(bufoff, gbase, voff) do { _Pragma("unroll") for (int _i = 0; _i < 2; ++_i) \
        __builtin_amdgcn_global_load_lds((const unsigned*)((const char*)(gbase) + (voff)[_i]), (PG8_LAS unsigned*)(lds + (bufoff) + ldsw + _i * 8192), 16, 0, 0); } while (0)
#define PG8_LDA(dst, b, h) do { _Pragma("unroll") for (int m = 0; m < 4; ++m) _Pragma("unroll") for (int k = 0; k < 2; ++k) dst[m][k] = *(const PG8_LAS bf16x8*)(lds + PG8_SA(b, h) + aoff + m * 2048 + k * 1024); } while (0)
#define PG8_LDB(dst, b, h) do { _Pragma("unroll") for (int n = 0; n < 2; ++n) _Pragma("unroll") for (int k = 0; k < 2; ++k) dst[n][k] = *(const PG8_LAS bf16x8*)(lds + PG8_SB(b, h) + boff + n * 2048 + k * 1024); } while (0)
#define PG8_MMA(ai, bj, At, Bt) do { __builtin_amdgcn_s_setprio(1); _Pragma("unroll") for (int m = 0; m < 4; ++m) _Pragma("unroll") for (int n = 0; n < 2; ++n) _Pragma("unroll") for (int k = 0; k < 2; ++k) \
        acc[ai][bj][m][n] = __builtin_amdgcn_mfma_f32_16x16x32_bf16(Bt[n][k], At[m][k], acc[ai][bj][m][n], 0, 0, 0); __builtin_amdgcn_s_setprio(0); } while (0)
#define PG8_WAIT_V(n) asm volatile("s_waitcnt vmcnt(" #n ")" ::: "memory")
#define PG8_WAIT_L(n) asm volatile("s_waitcnt lgkmcnt(" #n ")" ::: "memory")
#define PG8_BAR __builtin_amdgcn_s_barrier()
#define PG8_SCHED __builtin_amdgcn_sched_barrier(0)
    Unit cur, nxt; int ui = 0;
    if (!S.next(0, cur)) return;
    f32x4 acc[2][2][4][2];
#pragma unroll
    for (int a = 0; a < 2; ++a)
#pragma unroll
        for (int b = 0; b < 2; ++b)
#pragma unroll
            for (int m = 0; m < 4; ++m)
#pragma unroll
                for (int n = 0; n < 2; ++n) acc[a][b][m][n] = (f32x4){0.f, 0.f, 0.f, 0.f};
    bf16x8 At[4][2], B0[2][2], B1[2][2];
    const char* cA = (const char*)g.A + (size_t)cur.pm * tstep; const char* cB = (const char*)g.Bt + (size_t)cur.e * g.bstride + (size_t)cur.pn * tstep;
    S.a_ready(cur);
    if constexpr (SP2) {
        PG8_STAGE(PG8_SB(0, 0), cB, voffB); PG8_STAGE(PG8_SB(0, 1), cB + hstep, voffB); PG8_STAGE(PG8_SA(0, 0), cA, voffA); PG8_STAGE(PG8_SA(0, 1), cA + hstep, voffA);
        if (wr == 1) PG8_BAR;
        PG8_WAIT_V(2); PG8_BAR;
        PG8_STAGE(PG8_SB(1, 0), cB + kstep, voffB); PG8_STAGE(PG8_SA(1, 0), cA + kstep, voffA); PG8_STAGE(PG8_SB(1, 1), cB + hstep + kstep, voffB);
        PG8_WAIT_V(6); PG8_BAR;
    } else {
        PG8_STAGE(PG8_SB(0, 0), cB, voffB); PG8_STAGE(PG8_SA(0, 0), cA, voffA); PG8_STAGE(PG8_SB(0, 1), cB + hstep, voffB); PG8_STAGE(PG8_SA(0, 1), cA + hstep, voffA);
        if (wr == 1) PG8_BAR;
        PG8_WAIT_V(4); PG8_BAR;
        PG8_STAGE(PG8_SB(1, 0), cB + kstep, voffB); PG8_STAGE(PG8_SA(1, 0), cA + kstep, voffA); PG8_STAGE(PG8_SB(1, 1), cB + hstep + kstep, voffB);
        PG8_WAIT_V(6); PG8_BAR;
    }
    for (;;) {
        const bool has_next = S.next(ui + 1, nxt);
        const char* nA = has_next ? (const char*)g.A + (size_t)nxt.pm * tstep : cA; const char* nB = has_next ? (const char*)g.Bt + (size_t)nxt.e * g.bstride + (size_t)nxt.pn * tstep : cB;
        for (int t = 0; t < nt; t += 2) {
            const bool last = (t == nt - 2);
            const char* a1 = cA + (size_t)(t + 1) * kstep;
            const char* a2 = last ? nA : cA + (size_t)(t + 2) * kstep; const char* b2 = last ? nB : cB + (size_t)(t + 2) * kstep;
            const char* a3 = a2 + kstep; const char* b3 = b2 + kstep;
            if (last && has_next) S.a_ready(nxt);
            if constexpr (SP2) {
            PG8_LDB(B0, 0, 0); PG8_LDB(B1, 0, 1); PG8_SCHED; PG8_LDA(At, 0, 0); PG8_STAGE(PG8_SA(1, 1), a1 + hstep, voffA);
            PG8_WAIT_V(8); PG8_WAIT_L(0); PG8_BAR; PG8_MMA(0, 0, At, B0); PG8_MMA(0, 1, At, B1); PG8_BAR; PG8_SCHED;
            PG8_LDA(At, 0, 1); PG8_STAGE(PG8_SB(0, 0), b2, voffB); PG8_STAGE(PG8_SB(0, 1), b2 + hstep, voffB); PG8_STAGE(PG8_SA(0, 0), a2, voffA);
            PG8_WAIT_V(8); PG8_WAIT_L(0); PG8_BAR; PG8_MMA(1, 0, At, B0); PG8_MMA(1, 1, At, B1); PG8_BAR; PG8_SCHED;
            PG8_LDB(B0, 1, 0); PG8_LDB(B1, 1, 1); PG8_SCHED; PG8_LDA(At, 1, 0); PG8_STAGE(PG8_SA(0, 1), a2 + hstep, voffA);
            PG8_WAIT_V(8); PG8_WAIT_L(0); PG8_BAR; PG8_MMA(0, 0, At, B0); PG8_MMA(0, 1, At, B1); PG8_BAR; PG8_SCHED;
            PG8_LDA(At, 1, 1); PG8_STAGE(PG8_SB(1, 0), b3, voffB); PG8_STAGE(PG8_SB(1, 1), b3 + hstep, voffB); PG8_STAGE(PG8_SA(1, 0), a3, voffA);
            PG8_WAIT_V(8); PG8_WAIT_L(0); PG8_BAR; PG8_MMA(1, 0, At, B0); PG8_MMA(1, 1, At, B1); PG8_BAR; PG8_SCHED;
            } else {
            PG8_LDB(B0, 0, 0); PG8_SCHED; PG8_LDA(At, 0, 0); PG8_STAGE(PG8_SA(1, 1), a1 + hstep, voffA);
            PG8_WAIT_L(8); PG8_BAR; PG8_WAIT_L(0); PG8_MMA(0, 0, At, B0); PG8_BAR; PG8_SCHED;
            PG8_LDB(B1, 0, 1); PG8_STAGE(PG8_SB(0, 0), b2, voffB);
            PG8_BAR; PG8_WAIT_L(0); PG8_MMA(0, 1, At, B1); PG8_BAR;
            PG8_LDA(At, 0, 1); PG8_STAGE(PG8_SA(0, 0), a2, voffA);
            PG8_BAR; PG8_WAIT_L(0); PG8_MMA(1, 0, At, B0); PG8_BAR; PG8_SCHED;
            PG8_STAGE(PG8_SB(0, 1), b2 + hstep, voffB);
            PG8_WAIT_V(6); PG8_BAR; PG8_MMA(1, 1, At, B1); PG8_BAR;
            PG8_LDB(B0, 1, 0); PG8_SCHED; PG8_LDA(At, 1, 0); PG8_STAGE(PG8_SA(0, 1), a2 + hstep, voffA);
            PG8_WAIT_L(8); PG8_BAR; PG8_WAIT_L(0); PG8_MMA(0, 0, At, B0); PG8_BAR; PG8_SCHED;
            PG8_LDB(B1, 1, 1); PG8_STAGE(PG8_SB(1, 0), b3, voffB);
            PG8_BAR; PG8_WAIT_L(0); PG8_MMA(0, 1, At, B1); PG8_BAR;
            PG8_LDA(At, 1, 1); PG8_STAGE(PG8_SA(1, 0), a3, voffA);
            PG8_BAR; PG8_WAIT_L(0); PG8_MMA(1, 0, At, B0); PG8_BAR; PG8_SCHED;
            PG8_STAGE(PG8_SB(1, 1), b3 + hstep, voffB);
            PG8_WAIT_V(6); PG8_BAR; PG8_MMA(1, 1, At, B1); PG8_BAR;
            }
        }
        if constexpr (ALIGN_EPI) { if (wr == 0) PG8_BAR; }
        if constexpr (!Epi::AFTER_DRAIN) { E(acc, cur, wr, wc, fr, fq); S.done(cur); }
        if (!has_next) break;
#pragma unroll
        for (int a = 0; a < 2; ++a)
#pragma unroll
            for (int b = 0; b < 2; ++b)
#pragma unroll
                for (int m = 0; m < 4; ++m)
#pragma unroll
                    for (int n = 0; n < 2; ++n) acc[a][b][m][n] = (f32x4){0.f, 0.f, 0.f, 0.f};
        cur = nxt; cA = nA; cB = nB; ++ui;
        if constexpr (ALIGN_EPI) { if (wr == 1) PG8_BAR; }
    }
    PG8_WAIT_V(0);
    if constexpr (!ALIGN_EPI) { if (wr == 0) PG8_BAR; }
    PG8_BAR;
    if constexpr (Epi::AFTER_DRAIN) { E.fused(acc, cur, wr, wc, fr, fq, lds, wid, lane); S.done(cur); }
#undef PG8_SA
#undef PG8_SB
#undef PG8_STAGE
#undef PG8_LDA
#undef PG8_LDB
#undef PG8_MMA
#undef PG8_WAIT_V
#undef PG8_WAIT_L
#undef PG8_BAR
#undef PG8_SCHED
}
}

#define GAS __attribute__((address_space(1)))
#define LAS __attribute__((address_space(3)))
typedef unsigned short bf16;
typedef unsigned v4u __attribute__((ext_vector_type(4)));
typedef unsigned v2u __attribute__((ext_vector_type(2)));
typedef float f32x4 __attribute__((ext_vector_type(4)));
typedef float f32x2 __attribute__((ext_vector_type(2)));
typedef short bf16x8 __attribute__((ext_vector_type(8)));
typedef short s16x4 __attribute__((ext_vector_type(4)));
typedef int v4i __attribute__((ext_vector_type(4)));
#define RLX_AGENT __ATOMIC_RELAXED, __HIP_MEMORY_SCOPE_AGENT
#define LDS_WAIT() asm volatile("s_waitcnt lgkmcnt(0)" ::: "memory")
#define VM_WAIT() asm volatile("s_waitcnt vmcnt(0)" ::: "memory")

#ifndef MK_ONE_LAUNCH
#define MK_ONE_LAUNCH 0
#endif

constexpr int BATCH = 32, SEQ = 2048, D = 1024, DEPTH = 4, T = BATCH * SEQ;
constexpr int NH = 12, HD = 64, AW = 768, LW = 256, NIN = 2816, NE = 32, TOPK = 4, DFF = 1024;
constexpr float ALPHA = 1.6817928305074292f, LN_EPS = 1e-5f, RMS_EPS = 1e-6f, LOG2E = 1.4426950408889634f;
constexpr int NSLOT_MAX = T * TOPK + NE * 256;
constexpr int NPH_LAYER = 9, NPH = 2 + DEPTH * NPH_LAYER;

constexpr size_t MiB = 1u << 20;
constexpr size_t WS_CTL = 0, CTL_ZERO_BYTES = 1 * MiB;
constexpr size_t WS_MODS = 1 * MiB, WS_TOPI = 4 * MiB, WS_TOPW = 5 * MiB, WS_SLOT = 6 * MiB, WS_WGB = 7 * MiB;
constexpr size_t WS_LSE = 8 * MiB, WS_WIN = 18 * MiB, WS_WOUT = 40 * MiB, WS_W1 = 48 * MiB, WS_W2 = 560 * MiB;
constexpr size_t WS_U = 816 * MiB, WS_QKV = 944 * MiB, WS_ATTP = 1296 * MiB, WS_LRU = 1584 * MiB, WS_MIX = 1616 * MiB;
constexpr size_t WS_X = 1744 * MiB, WS_X1 = 2000 * MiB, WS_XG = 2256 * MiB, WS_ACT = 2784 * MiB, WS_END = 3312 * MiB;
static_assert((size_t)NSLOT_MAX * D * 2 <= 528 * MiB, "slot buffers");
constexpr int CW_TMO = 0, CW_BAR = 4096, CW_QCTR = 8192, CW_ETOT = 16384;

constexpr int RING_BYTES = 131072, MISC_OFF = RING_BYTES + 1024, LDS_BYTES = RING_BYTES + 8192;
constexpr int MW_TICKET = 4, MW_HIST = 16, MW_WGB = 48, MW_EBASE = 80, MW_TILEE = 128;

__device__ __forceinline__ unsigned f2bf(float f) { unsigned u = __builtin_bit_cast(unsigned, f); return (u + 0x7fffu + ((u >> 16) & 1u)) >> 16; }
__device__ __forceinline__ unsigned pk2(float lo, float hi) { unsigned r; asm volatile("v_cvt_pk_bf16_f32 %0, %1, %2" : "=v"(r) : "v"(lo), "v"(hi)); return r; }
__device__ __forceinline__ float bf_lo(unsigned w) { return __builtin_bit_cast(float, w << 16); }
__device__ __forceinline__ float bf_hi(unsigned w) { return __builtin_bit_cast(float, w & 0xffff0000u); }
__device__ __forceinline__ float ex2(float x) { return __builtin_amdgcn_exp2f(x); }
__device__ __forceinline__ float rcp(float x) { return __builtin_amdgcn_rcpf(x); }
__device__ __forceinline__ float sigmoidf_(float x) { return rcp(1.0f + ex2(-LOG2E * x)); }

#define XB_TMO      128
#define XB_XCNT(j)  (256  + 64 * (j))
#define XB_XSUB(j)  (1280 + 64 * (j))
#define XB_XGEN(j)  (2304 + 64 * (j))
#define XB_TOP      3328
#define XB_TOPGEN   3392
#define XCD_BAR_WORDS 3456
#define XB_SPIN_CAP (1u << 18)

__device__ __forceinline__ unsigned xb_ld(unsigned* p)              { return __hip_atomic_load(p, __ATOMIC_RELAXED, __HIP_MEMORY_SCOPE_AGENT); }
__device__ __forceinline__ unsigned xb_add(unsigned* p, unsigned v) { return __hip_atomic_fetch_add(p, v, __ATOMIC_RELAXED, __HIP_MEMORY_SCOPE_AGENT); }
__device__ __forceinline__ unsigned xb_xcc_id() { return (unsigned)__builtin_amdgcn_s_getreg((3 << 11) | 20) & 0xFu; }
#define XB_SPIN(cond, bar) do { unsigned _sp = 0; while (cond) { __builtin_amdgcn_s_sleep(1); \
    if ((++_sp & 255u) == 0u) { if (xb_ld(&(bar)[XB_TMO])) break; if (_sp > XB_SPIN_CAP) { atomicAdd(&(bar)[XB_TMO], 1u); break; } } } } while (0)

struct XcdBarrier {
    unsigned* bar; unsigned x;
    volatile LAS unsigned* st;
};

__device__ __forceinline__ XcdBarrier xcd_barrier_post(unsigned* bar, volatile LAS unsigned* st) {
    XcdBarrier b; b.bar = bar; b.x = xb_xcc_id(); b.st = st;
    if (threadIdx.x == 0) (void)xb_add(&bar[XB_XCNT(b.x)], 1u);
    return b;
}
__device__ __forceinline__ void xcd_barrier_complete(unsigned* bar, unsigned x, unsigned& nloc, unsigned& nx) {
    const unsigned G = gridDim.x * gridDim.y * gridDim.z;
    unsigned sum, cnt, mine, sp = 0u;
    for (;;) {
        sum = 0u; cnt = 0u; mine = 0u;
#pragma unroll
        for (unsigned j = 0; j < 16; ++j) { const unsigned c = xb_ld(&bar[XB_XCNT(j)]); sum += c; cnt += (c > 0u) ? 1u : 0u; mine = (j == x) ? c : mine; }
        if (sum == G) break;
        __builtin_amdgcn_s_sleep(1);
        if ((++sp & 255u) == 0u) { if (xb_ld(&bar[XB_TMO])) break; if (sp > XB_SPIN_CAP) { atomicAdd(&bar[XB_TMO], 1u); break; } }
    }
    nloc = mine > 0u ? mine : 1u; nx = cnt > 0u ? cnt : 1u;
}

__device__ __forceinline__ void xcd_barrier(const XcdBarrier& b) {
    asm volatile("s_waitcnt vmcnt(0)" ::: "memory");
    __syncthreads();
    if (threadIdx.x == 0) {
        unsigned* bar = b.bar;
        __builtin_amdgcn_s_waitcnt(0);
        unsigned nloc = b.st[0], nx = b.st[1];
        if (nloc == 0u) { xcd_barrier_complete(bar, b.x, nloc, nx); b.st[0] = nloc; b.st[1] = nx; }
        const unsigned old = xb_add(&bar[XB_XSUB(b.x)], 1u);
        const unsigned gen = old / nloc;
        if (old + 1u == (gen + 1u) * nloc) {
            __builtin_amdgcn_fence(__ATOMIC_RELEASE, "agent");
            asm volatile("s_waitcnt vmcnt(0)" ::: "memory");
            const unsigned og = xb_add(&bar[XB_TOP], 1u);
            const unsigned tg = og / nx;
            if (og + 1u == (tg + 1u) * nx) xb_add(&bar[XB_TOPGEN], 1u);
            else XB_SPIN(xb_ld(&bar[XB_TOPGEN]) == tg, bar);
            __builtin_amdgcn_fence(__ATOMIC_ACQUIRE, "agent");
            xb_add(&bar[XB_XGEN(b.x)], 1u);
            asm volatile("s_waitcnt vmcnt(0)" ::: "memory");
        } else {
            XB_SPIN(xb_ld(&bar[XB_XGEN(b.x)]) == gen, bar);
            __builtin_amdgcn_fence(__ATOMIC_ACQUIRE, "agent");
            asm volatile("s_waitcnt vmcnt(0)" ::: "memory");
        }
    }
    __syncthreads();
}

__device__ __forceinline__ float wave_sum(float v) {
#pragma unroll
    for (int o = 1; o < 64; o <<= 1) v += __shfl_xor(v, o);
    return v;
}
__device__ __forceinline__ float wave_max(float v) {
#pragma unroll
    for (int o = 1; o < 64; o <<= 1) v = fmaxf(v, __shfl_xor(v, o));
    return v;
}

struct Args { const float* in[25]; float* out; unsigned char* ws; int ph_lo, ph_hi; };
enum { I_X = 0, I_C, I_WCOND, I_BCOND, I_WIN, I_CONVW, I_CONVB, I_WA, I_BA, I_WX, I_BX, I_LAM, I_ANG, I_LNG, I_WOUT, I_LN1G, I_LN1B, I_RW, I_RB, I_W1, I_B1, I_W2, I_B2, I_LN2G, I_LN2B };

__device__ __forceinline__ void cvt_item(const float* W, int N, bf16* WTrow0, int k0, int n0, LAS float* scr, int lane) {
    f32x4 v[8];
#pragma unroll
    for (int i = 0; i < 8; ++i) { const int kk = 4 * i + (lane >> 4); v[i] = *(const GAS f32x4*)(W + (size_t)(k0 + kk) * N + n0 + 4 * (lane & 15)); }
#pragma unroll
    for (int i = 0; i < 8; ++i) { const int kk = 4 * i + (lane >> 4); LAS float* p = scr + kk * 65 + 4 * (lane & 15); p[0] = v[i][0]; p[1] = v[i][1]; p[2] = v[i][2]; p[3] = v[i][3]; }
    LDS_WAIT(); asm volatile("" ::: "memory");
#pragma unroll
    for (int j = 0; j < 4; ++j) { const int idx = lane + 64 * j, n = idx >> 2, c = idx & 3; const LAS float* s = scr + (8 * c) * 65 + n;
        v4u o; o.x = pk2(s[0 * 65], s[1 * 65]); o.y = pk2(s[2 * 65], s[3 * 65]); o.z = pk2(s[4 * 65], s[5 * 65]); o.w = pk2(s[6 * 65], s[7 * 65]);
        *(GAS v4u*)(WTrow0 + (size_t)n * D + k0 + 8 * c) = o; }
    LDS_WAIT(); asm volatile("" ::: "memory");
}
__device__ __forceinline__ void p0_convert(const Args& a, LAS unsigned char* lds, int gw, int NGW, int wave, int lane) {
    LAS float* scr = (LAS float*)(lds + wave * 8448);
    bf16* WIN = (bf16*)(a.ws + WS_WIN); bf16* WOUT = (bf16*)(a.ws + WS_WOUT); bf16* W1 = (bf16*)(a.ws + WS_W1); bf16* W2 = (bf16*)(a.ws + WS_W2);
    constexpr int KB = D / 32;
    constexpr int I_IN1 = KB * (NIN / 64), I_OUT1 = KB * (D / 64), I_W11 = KB * (2 * DFF / 64), I_W21 = KB * (D / 64);
    constexpr int N_IN = DEPTH * I_IN1, N_OUT = DEPTH * I_OUT1, N_W1 = DEPTH * NE * I_W11, N_W2 = DEPTH * NE * I_W21;
    for (int it = gw; it < N_IN + N_OUT + N_W1 + N_W2; it += NGW) {
        int r = it;
        if (r < N_IN) { const int l = r / I_IN1, q = r % I_IN1, nb = q / KB, kb = q % KB;
            cvt_item(a.in[I_WIN] + (size_t)l * D * NIN, NIN, WIN + (size_t)l * NIN * D + (size_t)(64 * nb) * D, 32 * kb, 64 * nb, scr, lane); continue; }
        r -= N_IN;
        if (r < N_OUT) { const int l = r / I_OUT1, q = r % I_OUT1, nb = q / KB, kb = q % KB;
            cvt_item(a.in[I_WOUT] + (size_t)l * D * D, D, WOUT + (size_t)l * D * D + (size_t)(64 * nb) * D, 32 * kb, 64 * nb, scr, lane); continue; }
        r -= N_OUT;
        if (r < N_W1) { const int le = r / I_W11, q = r % I_W11, nb = q / KB, kb = q % KB; const int n0 = 64 * nb;
            const int orow = n0 < DFF ? 256 * (n0 >> 7) + (n0 & 127) : 256 * ((n0 - DFF) >> 7) + 128 + ((n0 - DFF) & 127);
            cvt_item(a.in[I_W1] + (size_t)le * D * 2 * DFF, 2 * DFF, W1 + (size_t)le * 2 * DFF * D + (size_t)orow * D, 32 * kb, n0, scr, lane); continue; }
        r -= N_W1;
        { const int le = r / I_W21, q = r % I_W21, nb = q / KB, kb = q % KB;
            cvt_item(a.in[I_W2] + (size_t)le * DFF * D, D, W2 + (size_t)le * D * DFF + (size_t)(64 * nb) * DFF, 32 * kb, 64 * nb, scr, lane); }
    }
}
__device__ __forceinline__ void p0_mods(const Args& a, LAS unsigned char* lds, int wg, int G, int wave, int lane, int tid) {
    LAS float* sc = (LAS float*)lds;
    for (int i = tid; i < BATCH * D; i += 512) { const float x = a.in[I_C][i]; sc[i] = x * sigmoidf_(x); }
    __syncthreads();
    float* mods = (float*)(a.ws + WS_MODS);
    constexpr int NCH = DEPTH * 6 * D / 64;
    for (int ch = wg; ch < NCH; ch += G) {
        const int l = ch / (6 * D / 64), col = (ch % (6 * D / 64)) * 64 + lane;
        const float* w = a.in[I_WCOND] + (size_t)l * D * 6 * D + col;
        float acc[4] = {0.f, 0.f, 0.f, 0.f};
        const LAS float* s0 = sc + (4 * wave) * D;
        for (int d0 = 0; d0 < D; d0 += 4) {
            float wv[4];
#pragma unroll
            for (int j = 0; j < 4; ++j) wv[j] = *(const GAS float*)(w + (size_t)(d0 + j) * 6 * D);
#pragma unroll
            for (int bb = 0; bb < 4; ++bb) { const f32x4 s = *(const LAS f32x4*)(s0 + bb * D + d0); acc[bb] += s[0] * wv[0] + s[1] * wv[1] + s[2] * wv[2] + s[3] * wv[3]; }
        }
        const float bc = a.in[I_BCOND][l * 6 * D + col];
#pragma unroll
        for (int bb = 0; bb < 4; ++bb) mods[((size_t)l * BATCH + 4 * wave + bb) * 6 * D + col] = acc[bb] + bc;
    }
    __syncthreads();
}

__device__ __forceinline__ void ln_stats(const f32x4 (&v)[4], float& mean, float& rstd) {
    float s = 0.f;
#pragma unroll
    for (int j = 0; j < 4; ++j) s += (v[j][0] + v[j][1]) + (v[j][2] + v[j][3]);
    mean = wave_sum(s) * (1.f / D); float q = 0.f;
#pragma unroll
    for (int j = 0; j < 4; ++j) { const f32x4 d = v[j] - mean; q += (d[0] * d[0] + d[1] * d[1]) + (d[2] * d[2] + d[3] * d[3]); }
    rstd = rsqrtf(wave_sum(q) * (1.f / D) + LN_EPS);
}
__device__ __forceinline__ void load_row4(const float* p, int lane, f32x4 (&v)[4]) {
#pragma unroll
    for (int j = 0; j < 4; ++j) v[j] = *(const GAS f32x4*)(p + 4 * lane + 256 * j);
}
__device__ __forceinline__ void store_row_bf16(bf16* p, int lane, const f32x4 (&v)[4]) {
#pragma unroll
    for (int j = 0; j < 4; ++j) { v2u o; o.x = pk2(v[j][0], v[j][1]); o.y = pk2(v[j][2], v[j][3]); *(GAS v2u*)(p + 4 * lane + 256 * j) = o; }
}
__device__ __forceinline__ void mod_ln_row(const f32x4 (&x)[4], const float* sh, const float* sc, int lane, f32x4 (&u)[4]) {
    float mean, rstd; ln_stats(x, mean, rstd);
#pragma unroll
    for (int j = 0; j < 4; ++j) { const f32x4 s1 = *(const GAS f32x4*)(sc + 4 * lane + 256 * j), s0 = *(const GAS f32x4*)(sh + 4 * lane + 256 * j); u[j] = (x[j] - mean) * rstd * (1.0f + s1) + s0; }
}
__device__ __forceinline__ void p_r0(const Args& a, int gw, int NGW, int lane) {
    const float* mods = (const float*)(a.ws + WS_MODS); bf16* U = (bf16*)(a.ws + WS_U);
    for (int t = gw; t < T; t += NGW) { const int b = t / SEQ; const float* mb = mods + (size_t)b * 6 * D;
        f32x4 x[4], u[4]; load_row4(a.in[I_X] + (size_t)t * D, lane, x); mod_ln_row(x, mb, mb + D, lane, u); store_row_bf16(U + (size_t)t * D, lane, u); }
}

namespace att {
constexpr float C1 = 0.125f * 1.4426950408889634f;
typedef short v4i16_t __attribute__((ext_vector_type(4)));
__device__ __forceinline__ s16x4 vtr(const LAS unsigned char* p) { return __builtin_bit_cast(s16x4, __builtin_amdgcn_ds_read_tr16_b64_v4i16((LAS v4i16_t*)p)); }
__device__ __forceinline__ void stage(LAS unsigned char* buf, const bf16* qkv, int b, int h, int dil, int res, int n0, int wave, int lane) {
#pragma unroll
    for (int i = 0; i < 4; ++i) {
        const int blk8 = 4 * wave + i;
        if (n0 == 0 && blk8 < 16) continue;
        const int kk = 8 * blk8 + (lane >> 3), pos = lane & 7;
        const int t = res + dil * (n0 - 128 + kk);
        const char* rowp = (const char*)qkv + ((size_t)(b * SEQ + t) * NIN + AW + h * HD) * 2;
        const int cK = pos ^ ((kk >> 1) & 7), cV = pos ^ (((kk >> 1) & 3) << 1);
        __builtin_amdgcn_global_load_lds((const unsigned*)(rowp + cK * 16), (LAS unsigned*)(buf + blk8 * 1024), 16, 0, 0);
        __builtin_amdgcn_global_load_lds((const unsigned*)(rowp + AW * 2 + cV * 16), (LAS unsigned*)(buf + 32768 + blk8 * 1024), 16, 0, 0);
    }
}
__device__ __forceinline__ void load_q(const bf16* qkv, int b, int h, int dil, int res, int n0, int wave, int lane, bf16x8 (&qf)[2]) {
    const int fr = lane & 15, fq = lane >> 4;
    const size_t trow = (size_t)(b * SEQ + res + dil * (n0 + 16 * wave + fr));
    const bf16* qrow = qkv + trow * NIN + h * HD;
#pragma unroll
    for (int s = 0; s < 2; ++s) qf[s] = *(const GAS bf16x8*)(qrow + 32 * s + 8 * fq);
}
__device__ __forceinline__ void block(const LAS unsigned char* buf, const bf16x8 (&qf)[2], bf16* outp, float* lsep, int b, int h, int dil, int res, int n0, float slope2, int wave, int lane) {
    const int fr = lane & 15, fq = lane >> 4;
    const int qi = 16 * wave + fr;
    const size_t trow = (size_t)(b * SEQ + res + dil * (n0 + qi));
    f32x4 o[4];
#pragma unroll
    for (int mt = 0; mt < 4; ++mt) o[mt] = (f32x4){0.f, 0.f, 0.f, 0.f};
    float m = -1e30f, l = 0.f;
    const int kt_lo = (n0 == 0) ? 4 : (wave >> 1), kt_hi = (16 * wave + 143) >> 5;
    for (int kt = kt_lo; kt <= kt_hi; ++kt) {
        f32x4 s[2];
#pragma unroll
        for (int sub = 0; sub < 2; ++sub) {
            const int kk = 32 * kt + 16 * sub + fr; const LAS unsigned char* kp = buf + kk * 128; const int sw = (kk >> 1) & 7;
            const bf16x8 k0 = *(const LAS bf16x8*)(kp + ((fq ^ sw) << 4)), k1 = *(const LAS bf16x8*)(kp + (((4 + fq) ^ sw) << 4));
            f32x4 z = (f32x4){0.f, 0.f, 0.f, 0.f};
            z = __builtin_amdgcn_mfma_f32_16x16x32_bf16(k0, qf[0], z, 0, 0, 0);
            s[sub] = __builtin_amdgcn_mfma_f32_16x16x32_bf16(k1, qf[1], z, 0, 0, 0);
        }
        const int dbase = qi + 128 - 32 * kt - 4 * fq;
        float p[2][4]; float mx = -1e30f;
#pragma unroll
        for (int sub = 0; sub < 2; ++sub)
#pragma unroll
            for (int r = 0; r < 4; ++r) { const int d = dbase - 16 * sub - r; const float v = ((unsigned)d <= 128u) ? (s[sub][r] * C1 - slope2 * (float)d) : -1e30f; p[sub][r] = v; mx = fmaxf(mx, v); }
        mx = fmaxf(mx, __shfl_xor(mx, 16)); mx = fmaxf(mx, __shfl_xor(mx, 32));
        const float mn = fmaxf(m, mx), alpha = ex2(m - mn); m = mn;
        float rs = 0.f;
#pragma unroll
        for (int sub = 0; sub < 2; ++sub)
#pragma unroll
            for (int r = 0; r < 4; ++r) { p[sub][r] = ex2(p[sub][r] - mn); rs += p[sub][r]; }
        l = l * alpha + rs;
        v4u pw; pw.x = pk2(p[0][0], p[0][1]); pw.y = pk2(p[0][2], p[0][3]); pw.z = pk2(p[1][0], p[1][1]); pw.w = pk2(p[1][2], p[1][3]);
        const bf16x8 pf = __builtin_bit_cast(bf16x8, pw);
        const int q4 = fr >> 2, pp = fr & 3;
#pragma unroll
        for (int mt = 0; mt < 4; ++mt) {
            const int key0 = 32 * kt + 4 * fq + q4, key1 = key0 + 16, c = 2 * mt + (pp >> 1);
            const s16x4 lo = vtr(buf + 32768 + key0 * 128 + ((c ^ (((key0 >> 1) & 3) << 1)) << 4) + 8 * (pp & 1));
            const s16x4 hi = vtr(buf + 32768 + key1 * 128 + ((c ^ (((key1 >> 1) & 3) << 1)) << 4) + 8 * (pp & 1));
            const bf16x8 vf = __builtin_shufflevector(lo, hi, 0, 1, 2, 3, 4, 5, 6, 7);
            o[mt] = __builtin_amdgcn_mfma_f32_16x16x32_bf16(vf, pf, o[mt] * alpha, 0, 0, 0);
        }
    }
    l += __shfl_xor(l, 16); l += __shfl_xor(l, 32);
    const float inv = 1.0f / l;
    bf16* orow = outp + trow * AW + h * HD + 4 * fq;
#pragma unroll
    for (int mt = 0; mt < 4; ++mt) { v2u w; w.x = pk2(o[mt][0] * inv, o[mt][1] * inv); w.y = pk2(o[mt][2] * inv, o[mt][3] * inv); *(GAS v2u*)(orow + 16 * mt) = w; }
    if (fq == 0) lsep[trow * NH + h] = m + __builtin_amdgcn_logf(l);
}
__device__ __forceinline__ void ticket(LAS unsigned char* lds, const Args& a, int tk, int wave, int lane) {
    const bf16* qkv = (const bf16*)(a.ws + WS_QKV);
    const int bh = tk / 6, rem = tk % 6, patt = rem >> 1, half = rem & 1, b = bh / NH, h = bh % NH;
    const int dil = patt == 0 ? 1 : (patt == 1 ? 4 : 16);
    const float slope = h < 8 ? exp2f(-(float)(h + 1)) : exp2f(-(0.5f + (float)(h - 8)));
    const float slope2 = slope * (float)dil * LOG2E;
    bf16* outp = (bf16*)(a.ws + WS_ATTP) + (size_t)patt * T * AW; float* lsep = (float*)(a.ws + WS_LSE) + (size_t)patt * T * NH;
    int res, qb;
#define ATT_DESC(j) do { if (patt == 0) { res = 0; qb = 8 * half + (j); } else if (patt == 1) { res = 2 * half + ((j) >> 2); qb = (j) & 3; } else { res = 8 * half + (j); qb = 0; } } while (0)
    ATT_DESC(0); stage(lds, qkv, b, h, dil, res, 128 * qb, wave, lane);
    for (int j = 0; j < 8; ++j) {
        VM_WAIT(); __syncthreads();
        ATT_DESC(j); const int res_j = res, n0_j = 128 * qb;
        bf16x8 qf[2]; load_q(qkv, b, h, dil, res_j, n0_j, wave, lane, qf);
        if (j + 1 < 8) { ATT_DESC(j + 1); stage(lds + ((j + 1) & 1) * 65536, qkv, b, h, dil, res, 128 * qb, wave, lane); }
        block(lds + (j & 1) * 65536, qf, outp, lsep, b, h, dil, res_j, n0_j, slope2, wave, lane);
    }
#undef ATT_DESC
}
}
namespace lru {
constexpr int XC_OFF = 0, XCF_OFF = 16384, XG_OFF = XCF_OFF + 128 * 68 * 4, OUT_OFF = XG_OFF + 128 * 72 * 2, AGG_OFF = OUT_OFF + 128 * 72 * 2, WF_OFF = AGG_OFF + 4096;
static_assert(WF_OFF + 16384 <= RING_BYTES, "lru lds");
__device__ __forceinline__ void unit(LAS unsigned char* lds, const Args& a, int l, int tk, int wave, int lane, int tid) {
    const int b = tk >> 2, blk = tk & 3, fr = lane & 15, fq = lane >> 4;
    const bf16* qkv = (const bf16*)(a.ws + WS_QKV); bf16* outg = (bf16*)(a.ws + WS_LRU);
    LAS v4u* WF = (LAS v4u*)(lds + WF_OFF);
    {
#pragma unroll
      for (int ff = 0; ff < 2; ++ff) { const int f = 2 * wave + ff, gate = f >> 3, nt = (f >> 1) & 3, s = f & 1;
        const float* W = (gate ? a.in[I_WX] : a.in[I_WA]) + ((size_t)l * 4 + blk) * 64 * 64;
        const int k0 = 32 * s + 8 * fq, oc = 16 * nt + fr; v4u pa;
        pa.x = pk2(W[(k0 + 0) * 64 + oc], W[(k0 + 1) * 64 + oc]); pa.y = pk2(W[(k0 + 2) * 64 + oc], W[(k0 + 3) * 64 + oc]); pa.z = pk2(W[(k0 + 4) * 64 + oc], W[(k0 + 5) * 64 + oc]); pa.w = pk2(W[(k0 + 6) * 64 + oc], W[(k0 + 7) * 64 + oc]);
        WF[f * 64 + lane] = pa; } }
    float ba[4], bx[4], csp[4], carry[4];
#pragma unroll
    for (int nt = 0; nt < 4; ++nt) { const int ch = l * LW + 64 * blk + 16 * nt + fr; ba[nt] = a.in[I_BA][ch]; bx[nt] = a.in[I_BX][ch]; csp[nt] = 8.0f * log1pf(expf(-a.in[I_LAM][ch])); carry[nt] = 0.f; }
    const int c8 = tid & 7, chb = 64 * blk + 8 * c8;
    LAS unsigned char* XC = lds + XC_OFF; LAS float* XCF = (LAS float*)(lds + XCF_OFF); LAS bf16* XG = (LAS bf16*)(lds + XG_OFF); LAS bf16* OUT = (LAS bf16*)(lds + OUT_OFF); LAS float* AGG = (LAS float*)(lds + AGG_OFF);
    for (int tile = 0; tile < 16; ++tile) {
#pragma unroll
        for (int it = 0; it < 2; ++it) {
            const int ti = (tid >> 3) + 64 * it, s = 128 * tile + ti;
            const bf16* rowp = qkv + (size_t)(b * SEQ + s) * NIN + 2304 + chb;
            float xc[8];
#pragma unroll
            for (int e = 0; e < 8; ++e) xc[e] = a.in[I_CONVB][l * LW + chb + e];
#pragma unroll
            for (int j = 0; j < 4; ++j) { const int sp = s - 3 + j; v4u xr = (v4u){0u, 0u, 0u, 0u}; if (sp >= 0) xr = *(const GAS v4u*)(rowp - (size_t)(3 - j) * NIN);
                const float* cw = a.in[I_CONVW] + ((size_t)l * 4 + j) * LW + chb;
                xc[0] += cw[0] * bf_lo(xr.x); xc[1] += cw[1] * bf_hi(xr.x); xc[2] += cw[2] * bf_lo(xr.y); xc[3] += cw[3] * bf_hi(xr.y);
                xc[4] += cw[4] * bf_lo(xr.z); xc[5] += cw[5] * bf_hi(xr.z); xc[6] += cw[6] * bf_lo(xr.w); xc[7] += cw[7] * bf_hi(xr.w); }
            v4u xb; xb.x = pk2(xc[0], xc[1]); xb.y = pk2(xc[2], xc[3]); xb.z = pk2(xc[4], xc[5]); xb.w = pk2(xc[6], xc[7]);
            *(LAS v4u*)(XC + ti * 128 + ((c8 ^ ((ti >> 1) & 7)) << 4)) = xb;
            *(LAS f32x4*)(XCF + ti * 68 + 8 * c8) = (f32x4){xc[0], xc[1], xc[2], xc[3]}; *(LAS f32x4*)(XCF + ti * 68 + 8 * c8 + 4) = (f32x4){xc[4], xc[5], xc[6], xc[7]};
            *(LAS v4u*)(XG + ti * 72 + 8 * c8) = *(const GAS v4u*)(rowp + LW);
        }
        __syncthreads();
        f32x4 ga[4], gx[4];
        { const int tok = 16 * wave + fr, sw = (tok >> 1) & 7;
          const bf16x8 a0 = *(const LAS bf16x8*)(XC + tok * 128 + ((fq ^ sw) << 4)), a1 = *(const LAS bf16x8*)(XC + tok * 128 + (((4 + fq) ^ sw) << 4));
#pragma unroll
          for (int nt = 0; nt < 4; ++nt) { f32x4 z = (f32x4){0.f, 0.f, 0.f, 0.f};
              const bf16x8 wa0 = __builtin_bit_cast(bf16x8, WF[(nt * 2 + 0) * 64 + lane]), wa1 = __builtin_bit_cast(bf16x8, WF[(nt * 2 + 1) * 64 + lane]);
              const bf16x8 wx0 = __builtin_bit_cast(bf16x8, WF[(8 + nt * 2 + 0) * 64 + lane]), wx1 = __builtin_bit_cast(bf16x8, WF[(8 + nt * 2 + 1) * 64 + lane]);
              ga[nt] = __builtin_amdgcn_mfma_f32_16x16x32_bf16(a1, wa1, __builtin_amdgcn_mfma_f32_16x16x32_bf16(a0, wa0, z, 0, 0, 0), 0, 0, 0);
              gx[nt] = __builtin_amdgcn_mfma_f32_16x16x32_bf16(a1, wx1, __builtin_amdgcn_mfma_f32_16x16x32_bf16(a0, wx0, z, 0, 0, 0), 0, 0, 0); } }
        float av[4][4], bv[4][4], Aex[4], Hex[4];
#pragma unroll
        for (int nt = 0; nt < 4; ++nt) {
            const int ch = 16 * nt + fr; float A4 = 1.f, H4 = 0.f;
#pragma unroll
            for (int r = 0; r < 4; ++r) { const int tok2 = 16 * wave + 4 * fq + r;
                const float rg = sigmoidf_(ga[nt][r] + ba[nt]), ig = sigmoidf_(gx[nt][r] + bx[nt]);
                const float la = -csp[nt] * rg, x2 = 2.0f * la, aa = ex2(la * LOG2E);
                const float ser = -x2 * (1.0f + x2 * (0.5f + x2 * (0.16666667f + x2 * (0.041666668f + x2 * 0.0083333338f))));
                const float om = (x2 > -0.3f) ? ser : (1.0f - aa * aa);
                const float bb = sqrtf(om) * ig * XCF[tok2 * 68 + ch];
                av[nt][r] = aa; bv[nt][r] = bb; H4 = aa * H4 + bb; A4 *= aa; }
            float Ap = __shfl_up(A4, 16), Hp = __shfl_up(H4, 16); if (fq >= 1) { H4 = A4 * Hp + H4; A4 = A4 * Ap; }
            Ap = __shfl_up(A4, 32); Hp = __shfl_up(H4, 32); if (fq >= 2) { H4 = A4 * Hp + H4; A4 = A4 * Ap; }
            Aex[nt] = __shfl_up(A4, 16); Hex[nt] = __shfl_up(H4, 16); if (fq == 0) { Aex[nt] = 1.f; Hex[nt] = 0.f; }
            if (fq == 3) { AGG[(wave * 64 + ch) * 2] = A4; AGG[(wave * 64 + ch) * 2 + 1] = H4; }
        }
        __syncthreads();
#pragma unroll
        for (int nt = 0; nt < 4; ++nt) {
            const int ch = 16 * nt + fr; float h = carry[nt], hw = carry[nt];
#pragma unroll
            for (int w2 = 0; w2 < 8; ++w2) { if (w2 == wave) hw = h; const float A = AGG[(w2 * 64 + ch) * 2], H = AGG[(w2 * 64 + ch) * 2 + 1]; h = A * h + H; }
            carry[nt] = h;
            float hl = Aex[nt] * hw + Hex[nt];
#pragma unroll
            for (int r = 0; r < 4; ++r) { const int tok2 = 16 * wave + 4 * fq + r; hl = av[nt][r] * hl + bv[nt][r];
                const float g = __builtin_bit_cast(float, (unsigned)XG[tok2 * 72 + ch] << 16);
                const float y = hl * g * sigmoidf_(1.5957691216f * (g + 0.044715f * g * g * g));
                OUT[tok2 * 72 + ch] = (bf16)f2bf(y); }
        }
        __syncthreads();
#pragma unroll
        for (int it = 0; it < 2; ++it) { const int ti = (tid >> 3) + 64 * it, s = 128 * tile + ti;
            *(GAS v4u*)(outg + (size_t)(b * SEQ + s) * LW + chb) = *(const LAS v4u*)(OUT + ti * 72 + 8 * c8); }
    }
}
}

__device__ __forceinline__ void merge_chunk(const bf16* ATTP, const float* LSE, int t, int c, float (&v)[8]) {
    const int head = c >> 3;
    const float l0 = LSE[(size_t)t * NH + head], l1 = LSE[(size_t)T * NH + (size_t)t * NH + head], l2 = LSE[(size_t)2 * T * NH + (size_t)t * NH + head];
    const float mx = fmaxf(l0, fmaxf(l1, l2)); float w0 = ex2(l0 - mx), w1 = ex2(l1 - mx), w2 = ex2(l2 - mx); const float inv = 1.0f / (w0 + w1 + w2); w0 *= inv; w1 *= inv; w2 *= inv;
    const v4u p0 = *(const GAS v4u*)(ATTP + (size_t)t * AW + 8 * c), p1 = *(const GAS v4u*)(ATTP + (size_t)T * AW + (size_t)t * AW + 8 * c), p2 = *(const GAS v4u*)(ATTP + (size_t)2 * T * AW + (size_t)t * AW + 8 * c);
    v[0] = w0 * bf_lo(p0.x) + w1 * bf_lo(p1.x) + w2 * bf_lo(p2.x); v[1] = w0 * bf_hi(p0.x) + w1 * bf_hi(p1.x) + w2 * bf_hi(p2.x);
    v[2] = w0 * bf_lo(p0.y) + w1 * bf_lo(p1.y) + w2 * bf_lo(p2.y); v[3] = w0 * bf_hi(p0.y) + w1 * bf_hi(p1.y) + w2 * bf_hi(p2.y);
    v[4] = w0 * bf_lo(p0.z) + w1 * bf_lo(p1.z) + w2 * bf_lo(p2.z); v[5] = w0 * bf_hi(p0.z) + w1 * bf_hi(p1.z) + w2 * bf_hi(p2.z);
    v[6] = w0 * bf_lo(p0.w) + w1 * bf_lo(p1.w) + w2 * bf_lo(p2.w); v[7] = w0 * bf_hi(p0.w) + w1 * bf_hi(p1.w) + w2 * bf_hi(p2.w);
}
__device__ __forceinline__ void p_merge(const Args& a, int l, int gw, int NGW, int lane) {
    const bf16* ATTP = (const bf16*)(a.ws + WS_ATTP); const float* LSE = (const float*)(a.ws + WS_LSE); const bf16* LRU = (const bf16*)(a.ws + WS_LRU); bf16* A2 = (bf16*)(a.ws + WS_U);
    const float* ang = a.in[I_ANG] + l * AW; const float* lng = a.in[I_LNG] + l * LW;
    const bool at1 = lane < 32;
    for (int t = gw; t < T; t += NGW) {
        float v0[8], v1[8];
        merge_chunk(ATTP, LSE, t, lane, v0);
        if (at1) merge_chunk(ATTP, LSE, t, 64 + lane, v1);
        else { const v4u p = *(const GAS v4u*)(LRU + (size_t)t * LW + 8 * (lane - 32)); v1[0] = bf_lo(p.x); v1[1] = bf_hi(p.x); v1[2] = bf_lo(p.y); v1[3] = bf_hi(p.y); v1[4] = bf_lo(p.z); v1[5] = bf_hi(p.z); v1[6] = bf_lo(p.w); v1[7] = bf_hi(p.w); }
        float s0 = 0.f, s1 = 0.f;
#pragma unroll
        for (int e = 0; e < 8; ++e) { s0 += v0[e] * v0[e]; s1 += v1[e] * v1[e]; }
        const float ssa = wave_sum(s0 + (at1 ? s1 : 0.f)), ssl = wave_sum(at1 ? 0.f : s1);
        const float ra = rsqrtf(ssa * (1.0f / AW) + RMS_EPS), rl = rsqrtf(ssl * (1.0f / LW) + RMS_EPS);
        const float* g0 = ang + 8 * lane; const float* g1 = at1 ? ang + 512 + 8 * lane : lng + 8 * (lane - 32); const float r1 = at1 ? ra : rl;
        v4u o0, o1;
        o0.x = pk2(v0[0] * ra * g0[0], v0[1] * ra * g0[1]); o0.y = pk2(v0[2] * ra * g0[2], v0[3] * ra * g0[3]); o0.z = pk2(v0[4] * ra * g0[4], v0[5] * ra * g0[5]); o0.w = pk2(v0[6] * ra * g0[6], v0[7] * ra * g0[7]);
        o1.x = pk2(v1[0] * r1 * g1[0], v1[1] * r1 * g1[1]); o1.y = pk2(v1[2] * r1 * g1[2], v1[3] * r1 * g1[3]); o1.z = pk2(v1[4] * r1 * g1[4], v1[5] * r1 * g1[5]); o1.w = pk2(v1[6] * r1 * g1[6], v1[7] * r1 * g1[7]);
        *(GAS v4u*)(A2 + (size_t)t * D + 8 * lane) = o0; *(GAS v4u*)(A2 + (size_t)t * D + 512 + 8 * lane) = o1;
    }
}

constexpr int RWP = 1028;
__device__ __forceinline__ void p_r2(const Args& a, LAS unsigned char* lds, volatile LAS unsigned* MISC, int l, int wg, int G, int wave, int lane, int tid) {
    LAS float* rwT = (LAS float*)lds;
    { const float* rw = a.in[I_RW] + (size_t)l * D * NE;
      for (int i = tid; i < D * NE; i += 512) rwT[(i & 31) * RWP + (i >> 5)] = rw[i]; }
    const float* mods = (const float*)(a.ws + WS_MODS); const float* xin = l == 0 ? a.in[I_X] : (const float*)(a.ws + WS_X);
    const bf16* MIX = (const bf16*)(a.ws + WS_MIX); float* X1 = (float*)(a.ws + WS_X1); bf16* U = (bf16*)(a.ws + WS_U);
    int* TOPI = (int*)(a.ws + WS_TOPI); float* TOPW = (float*)(a.ws + WS_TOPW); unsigned* WGB = (unsigned*)(a.ws + WS_WGB);
    unsigned* etot = (unsigned*)(a.ws + WS_CTL) + CW_ETOT + 64 * l;
    const float* l1g = a.in[I_LN1G] + l * D; const float* l1b = a.in[I_LN1B] + l * D; const float rbias = a.in[I_RB][l * NE + ((lane >> 1) & 31)];
    for (int chunk = wg; chunk < T / 256; chunk += G) {
        if (tid < 32) MISC[MW_HIST + tid] = 0u;
        __syncthreads();
        for (int i = 0; i < 32; ++i) {
            const int t = 256 * chunk + 32 * wave + i, b = t / SEQ; const float* mb = mods + ((size_t)l * BATCH + b) * 6 * D;
            f32x4 x[4], u[4]; load_row4(xin + (size_t)t * D, lane, x);
#pragma unroll
            for (int j = 0; j < 4; ++j) { const v2u mw = *(const GAS v2u*)(MIX + (size_t)t * D + 4 * lane + 256 * j); const f32x4 g1 = *(const GAS f32x4*)(mb + 2 * D + 4 * lane + 256 * j);
                const f32x4 mx = (f32x4){bf_lo(mw.x), bf_hi(mw.x), bf_lo(mw.y), bf_hi(mw.y)}; x[j] = ALPHA * x[j] + (1.0f + g1) * mx; }
            float mean, rstd; ln_stats(x, mean, rstd);
#pragma unroll
            for (int j = 0; j < 4; ++j) { const f32x4 g = *(const GAS f32x4*)(l1g + 4 * lane + 256 * j), bb = *(const GAS f32x4*)(l1b + 4 * lane + 256 * j); x[j] = (x[j] - mean) * rstd * g + bb;
                *(GAS f32x4*)(X1 + (size_t)t * D + 4 * lane + 256 * j) = x[j]; }
            mod_ln_row(x, mb + 3 * D, mb + 4 * D, lane, u);
            store_row_bf16(U + (size_t)t * D, lane, u);
            float pl[32];
#pragma unroll
            for (int e = 0; e < 32; ++e) { f32x2 acc = (f32x2){0.f, 0.f};
#pragma unroll
                for (int j = 0; j < 4; ++j) { const f32x4 w = *(const LAS f32x4*)(rwT + e * RWP + 4 * lane + 256 * j); acc += (f32x2){w[0], w[1]} * (f32x2){u[j][0], u[j][1]}; acc += (f32x2){w[2], w[3]} * (f32x2){u[j][2], u[j][3]}; }
                pl[e] = acc[0] + acc[1]; }
            float q16[16], q8[8], q4[4], q2[2], lg;
            { const bool hi = (lane & 32) != 0;
#pragma unroll
              for (int k = 0; k < 16; ++k) { const float mine = hi ? pl[16 + k] : pl[k], send = hi ? pl[k] : pl[16 + k]; q16[k] = mine + __shfl_xor(send, 32); } }
            { const bool hi = (lane & 16) != 0;
#pragma unroll
              for (int k = 0; k < 8; ++k) { const float mine = hi ? q16[8 + k] : q16[k], send = hi ? q16[k] : q16[8 + k]; q8[k] = mine + __shfl_xor(send, 16); } }
            { const bool hi = (lane & 8) != 0;
#pragma unroll
              for (int k = 0; k < 4; ++k) { const float mine = hi ? q8[4 + k] : q8[k], send = hi ? q8[k] : q8[4 + k]; q4[k] = mine + __shfl_xor(send, 8); } }
            { const bool hi = (lane & 4) != 0;
#pragma unroll
              for (int k = 0; k < 2; ++k) { const float mine = hi ? q4[2 + k] : q4[k], send = hi ? q4[k] : q4[2 + k]; q2[k] = mine + __shfl_xor(send, 4); } }
            { const bool hi = (lane & 2) != 0; const float mine = hi ? q2[1] : q2[0], send = hi ? q2[0] : q2[1]; lg = mine + __shfl_xor(send, 2); }
            lg += __shfl_xor(lg, 1); lg += rbias;
            int si[4]; float sv[4];
#pragma unroll
            for (int k = 0; k < 4; ++k) { const float mx = wave_max(lg); const unsigned long long bal = __ballot(lg == mx); const int first = __ffsll((long long)bal) - 1; si[k] = first >> 1; sv[k] = mx; if ((lane >> 1) == si[k]) lg = -3.0e38f; }
            const float e1 = ex2((sv[1] - sv[0]) * LOG2E), e2 = ex2((sv[2] - sv[0]) * LOG2E), e3 = ex2((sv[3] - sv[0]) * LOG2E), inv = 1.0f / (1.0f + e1 + e2 + e3);
            if (lane == 0) { *(GAS v4i*)(TOPI + (size_t)t * 4) = (v4i){si[0], si[1], si[2], si[3]}; *(GAS f32x4*)(TOPW + (size_t)t * 4) = (f32x4){inv, e1 * inv, e2 * inv, e3 * inv};
#pragma unroll
                for (int k = 0; k < 4; ++k) __hip_atomic_fetch_add((LAS unsigned*)(MISC + MW_HIST + si[k]), 1u, __ATOMIC_RELAXED, __HIP_MEMORY_SCOPE_WORKGROUP); }
        }
        __syncthreads();
        if (tid < 32) { const unsigned c = MISC[MW_HIST + tid]; WGB[chunk * 32 + tid] = __hip_atomic_fetch_add(etot + tid, c, RLX_AGENT); }
        __syncthreads();
    }
}
__device__ __forceinline__ int build_tiles(const Args& a, volatile LAS unsigned* MISC, int l, int tid) {
    unsigned* etot = (unsigned*)(a.ws + WS_CTL) + CW_ETOT + 64 * l;
    __syncthreads();
    if (tid == 0) { unsigned acc = 0; for (int e = 0; e < NE; ++e) { MISC[MW_EBASE + e] = acc; const unsigned c = __hip_atomic_load(etot + e, RLX_AGENT); acc += ((c + 255u) >> 8) << 8; } MISC[MW_EBASE + NE] = acc; }
    __syncthreads();
    const int ntiles = (int)(MISC[MW_EBASE + NE] >> 8);
    volatile LAS unsigned short* te = (volatile LAS unsigned short*)(MISC + MW_TILEE);
    for (int pm = tid; pm < ntiles; pm += 512) { int e = 0; for (int k = 1; k < NE; ++k) if (MISC[MW_EBASE + k] <= (unsigned)pm * 256u) e = k; te[pm] = (unsigned short)e; }
    __syncthreads();
    return ntiles;
}
__device__ __forceinline__ void p_dispatch(const Args& a, LAS unsigned char* lds, volatile LAS unsigned* MISC, int l, int wg, int G, int wave, int lane, int tid) {
    build_tiles(a, MISC, l, tid);
    const int* TOPI = (const int*)(a.ws + WS_TOPI); int* SLOT = (int*)(a.ws + WS_SLOT); const unsigned* WGB = (const unsigned*)(a.ws + WS_WGB);
    const bf16* U = (const bf16*)(a.ws + WS_U); bf16* XG = (bf16*)(a.ws + WS_XG);
    LAS int* slotl = (LAS int*)lds;
    for (int chunk = wg; chunk < T / 256; chunk += G) {
        if (tid < 32) { MISC[MW_HIST + tid] = 0u; MISC[MW_WGB + tid] = WGB[chunk * 32 + tid]; }
        __syncthreads();
#pragma unroll
        for (int it = 0; it < 2; ++it) { const int p = tid + 512 * it; const int e = TOPI[(size_t)256 * chunk * 4 + p];
            const unsigned r = __hip_atomic_fetch_add((LAS unsigned*)(MISC + MW_HIST + e), 1u, __ATOMIC_RELAXED, __HIP_MEMORY_SCOPE_WORKGROUP);
            const int slot = (int)(MISC[MW_EBASE + e] + MISC[MW_WGB + e] + r); SLOT[(size_t)256 * chunk * 4 + p] = slot; slotl[p] = slot; }
        __syncthreads();
        for (int p = wave; p < 1024; p += 8) { const int t = 256 * chunk + (p >> 2); const int slot = slotl[p];
            const GAS v4u* src = (const GAS v4u*)(U + (size_t)t * D); GAS v4u* dst = (GAS v4u*)(XG + (size_t)slot * D);
            const v4u c0 = src[lane], c1 = src[lane + 64]; dst[lane] = c0; dst[lane + 64] = c1; }
        __syncthreads();
    }
}
__device__ __forceinline__ void p_r3(const Args& a, int l, int gw, int NGW, int lane) {
    const float* mods = (const float*)(a.ws + WS_MODS); const float* X1 = (const float*)(a.ws + WS_X1); const bf16* Z = (const bf16*)(a.ws + WS_XG);
    const int* SLOT = (const int*)(a.ws + WS_SLOT); const float* TOPW = (const float*)(a.ws + WS_TOPW);
    float* xo = l == DEPTH - 1 ? a.out : (float*)(a.ws + WS_X); bf16* U = (bf16*)(a.ws + WS_U);
    const float* l2g = a.in[I_LN2G] + l * D; const float* l2b = a.in[I_LN2B] + l * D;
    for (int t = gw; t < T; t += NGW) {
        const int b = t / SEQ; const float* mb = mods + ((size_t)l * BATCH + b) * 6 * D;
        const v4i sl = *(const GAS v4i*)(SLOT + (size_t)t * 4); const f32x4 wt = *(const GAS f32x4*)(TOPW + (size_t)t * 4);
        const int sls[4] = {sl[0], sl[1], sl[2], sl[3]};
        f32x4 f[4], x[4];
#pragma unroll
        for (int j = 0; j < 4; ++j) f[j] = (f32x4){0.f, 0.f, 0.f, 0.f};
#pragma unroll
        for (int k = 0; k < 4; ++k) { const bf16* zr = Z + (size_t)sls[k] * D;
#pragma unroll
            for (int j = 0; j < 4; ++j) { const v2u w = *(const GAS v2u*)(zr + 4 * lane + 256 * j); f[j] += wt[k] * (f32x4){bf_lo(w.x), bf_hi(w.x), bf_lo(w.y), bf_hi(w.y)}; } }
        load_row4(X1 + (size_t)t * D, lane, x);
#pragma unroll
        for (int j = 0; j < 4; ++j) { const f32x4 g2 = *(const GAS f32x4*)(mb + 5 * D + 4 * lane + 256 * j); x[j] = ALPHA * x[j] + (1.0f + g2) * f[j]; }
        float mean, rstd; ln_stats(x, mean, rstd);
#pragma unroll
        for (int j = 0; j < 4; ++j) { const f32x4 g = *(const GAS f32x4*)(l2g + 4 * lane + 256 * j), bb = *(const GAS f32x4*)(l2b + 4 * lane + 256 * j); x[j] = (x[j] - mean) * rstd * g + bb;
            *(GAS f32x4*)(xo + (size_t)t * D + 4 * lane + 256 * j) = x[j]; }
        if (l + 1 < DEPTH) { const float* mn = mods + ((size_t)(l + 1) * BATCH + b) * 6 * D; f32x4 u[4]; mod_ln_row(x, mn, mn + D, lane, u); store_row_bf16(U + (size_t)t * D, lane, u); }
    }
}

__global__ void __launch_bounds__(512, 2) fwd(Args a) {
    extern __shared__ __attribute__((aligned(16))) unsigned char lds_raw[];
    LAS unsigned char* lds = (LAS unsigned char*)lds_raw;
    volatile LAS unsigned* MISC = (volatile LAS unsigned*)(lds + MISC_OFF);
    const int tid = threadIdx.x, lane = tid & 63, wave = __builtin_amdgcn_readfirstlane(tid >> 6), G = gridDim.x, wg = blockIdx.x;
    const int gw = wg * 8 + wave, NGW = G * 8;
    unsigned* ctl = (unsigned*)(a.ws + WS_CTL);
    for (int u = tid; u < (LDS_BYTES - MISC_OFF) / 4; u += 512) MISC[u] = 0u;
    __syncthreads();
#if MK_ONE_LAUNCH
    XcdBarrier bar = xcd_barrier_post(ctl + CW_BAR, MISC);
#define GRID_BAR() xcd_barrier(bar)
#else
#define GRID_BAR() do { } while (0)
#endif
    const int lo = a.ph_lo, hi = a.ph_hi;
#define IN(k) (lo <= (k) && (k) < hi)
#define BOTH(k) (IN(k) && IN((k) + 1))
#ifndef ONLY_PHASE
#define ONLY_PHASE -1
#endif
#define PH_ON(k) (ONLY_PHASE < 0 || ONLY_PHASE == (k))
    if (PH_ON(100) && IN(0)) { p0_mods(a, lds, wg, G, wave, lane, tid); p0_convert(a, lds, gw, NGW, wave, lane); if (BOTH(0)) GRID_BAR(); }
    if (PH_ON(101) && IN(1)) { p_r0(a, gw, NGW, lane); if (BOTH(1)) GRID_BAR(); }
#pragma unroll 1
    for (int l = 0; l < DEPTH; ++l) {
        const int g0 = 2 + NPH_LAYER * l;
#define OPAQUE_TID() int tid = threadIdx.x; asm volatile("" : "+v"(tid)); const int lane = tid & 63; const int wave = __builtin_amdgcn_readfirstlane(tid >> 6); const int gw = wg * 8 + wave; (void)lane; (void)gw
        if (PH_ON(0) && IN(g0 + 0)) { OPAQUE_TID();
            pg8::Gemm g{(const bf16*)(a.ws + WS_U), (const bf16*)(a.ws + WS_WIN) + (size_t)l * NIN * D, D, 0};
            pg8::TileOrder S; S.init(T / 256, NIN / 256, G, wg, nullptr);
            pg8::EpiBf16 E{(bf16*)(a.ws + WS_QKV), NIN, nullptr, 0};
            pg8::gemm_phase<pg8::EpiBf16, pg8::TileOrder, true, true>(lds, g, S, E, tid);
            if (BOTH(g0 + 0)) GRID_BAR();
        }
        if (PH_ON(1) && IN(g0 + 1)) { OPAQUE_TID();
            unsigned* qctr = ctl + CW_QCTR + 64 * l;
            constexpr int NTK = 128 + BATCH * NH * 6;
            for (;;) {
                if (tid == 0) MISC[MW_TICKET] = __hip_atomic_fetch_add(qctr, 1u, RLX_AGENT);
                __syncthreads();
                const int tk = (int)MISC[MW_TICKET];
                __syncthreads();
                if (tk >= NTK) break;
                if (tk < 128) lru::unit(lds, a, l, tk, wave, lane, tid); else att::ticket(lds, a, tk - 128, wave, lane);
            }
            if (BOTH(g0 + 1)) GRID_BAR();
        }
        if (PH_ON(2) && IN(g0 + 2)) { OPAQUE_TID(); p_merge(a, l, gw, NGW, lane); if (BOTH(g0 + 2)) GRID_BAR(); }
        if (PH_ON(3) && IN(g0 + 3)) { OPAQUE_TID();
            pg8::Gemm g{(const bf16*)(a.ws + WS_U), (const bf16*)(a.ws + WS_WOUT) + (size_t)l * D * D, D, 0};
            pg8::TileOrder S; S.init(T / 256, D / 256, G, wg, nullptr);
            pg8::EpiBf16 E{(bf16*)(a.ws + WS_MIX), D, nullptr, 0};
            pg8::gemm_phase<pg8::EpiBf16, pg8::TileOrder, true, true>(lds, g, S, E, tid);
            if (BOTH(g0 + 3)) GRID_BAR();
        }
        if (PH_ON(4) && IN(g0 + 4)) { OPAQUE_TID(); p_r2(a, lds, MISC, l, wg, G, wave, lane, tid); if (BOTH(g0 + 4)) GRID_BAR(); }
        if (PH_ON(5) && IN(g0 + 5)) { OPAQUE_TID(); p_dispatch(a, lds, MISC, l, wg, G, wave, lane, tid); if (BOTH(g0 + 5)) GRID_BAR(); }
        if (PH_ON(6) && IN(g0 + 6)) { OPAQUE_TID();
            const int ntiles = build_tiles(a, MISC, l, tid);
            pg8::Gemm g{(const bf16*)(a.ws + WS_XG), (const bf16*)(a.ws + WS_W1) + (size_t)l * NE * 2 * DFF * D, D, (size_t)2 * DFF * D * 2};
            pg8::TileOrder S; S.init(ntiles, 8, G, wg, (const LAS unsigned short*)(MISC + MW_TILEE));
            pg8::EpiSwiglu E{(bf16*)(a.ws + WS_ACT), a.in[I_B1] + (size_t)l * NE * 2 * DFF};
            pg8::gemm_phase<pg8::EpiSwiglu, pg8::TileOrder, true, true>(lds, g, S, E, tid);
            if (BOTH(g0 + 6)) GRID_BAR();
        }
        if (PH_ON(7) && IN(g0 + 7)) { OPAQUE_TID();
            const int ntiles = build_tiles(a, MISC, l, tid);
            pg8::Gemm g{(const bf16*)(a.ws + WS_ACT), (const bf16*)(a.ws + WS_W2) + (size_t)l * NE * D * DFF, DFF, (size_t)D * DFF * 2};
            pg8::TileOrder S; S.init(ntiles, 4, G, wg, (const LAS unsigned short*)(MISC + MW_TILEE));
            pg8::EpiBf16 E{(bf16*)(a.ws + WS_XG), D, a.in[I_B2] + (size_t)l * NE * D, D};
            pg8::gemm_phase<pg8::EpiBf16, pg8::TileOrder, true, true>(lds, g, S, E, tid);
            if (BOTH(g0 + 7)) GRID_BAR();
        }
        if (PH_ON(8) && IN(g0 + 8)) { OPAQUE_TID(); p_r3(a, l, gw, NGW, lane); if (BOTH(g0 + 8)) GRID_BAR(); }
    }
}

extern "C" void kernel_launch(void* const* d_in, const int* in_sizes, int n_in, void* d_out, int out_size, void* d_ws, size_t ws_size, hipStream_t stream) {
    static int grid = 0;
    if (grid == 0) {
        if (n_in != 25 || out_size != T * D || ws_size < WS_END) { fprintf(stderr, "kernel_launch: unexpected shapes (n_in %d out %d ws %zu)\n", n_in, out_size, ws_size); grid = -1; return; }
        int dev = 0, cus = 0, per_cu = 0;
        if (hipGetDevice(&dev) != hipSuccess || hipDeviceGetAttribute(&cus, hipDeviceAttributeMultiprocessorCount, dev) != hipSuccess) { grid = -1; return; }
        if (hipFuncSetAttribute((const void*)fwd, hipFuncAttributeMaxDynamicSharedMemorySize, LDS_BYTES) != hipSuccess) { fprintf(stderr, "kernel_launch: hipFuncSetAttribute failed\n"); grid = -1; return; }
        if (hipOccupancyMaxActiveBlocksPerMultiprocessor(&per_cu, (const void*)fwd, 512, LDS_BYTES) != hipSuccess || per_cu < 1) fprintf(stderr, "kernel_launch: occupancy query reports %d\n", per_cu);
        (void)hipGetLastError();
        grid = cus;
    }
    if (grid < 0) return;
    (void)hipMemsetAsync((char*)d_ws + WS_CTL, 0, CTL_ZERO_BYTES, stream);
    Args a{};
    for (int i = 0; i < 25; ++i) a.in[i] = (const float*)d_in[i];
    a.out = (float*)d_out; a.ws = (unsigned char*)d_ws;
#if MK_ONE_LAUNCH
    a.ph_lo = 0; a.ph_hi = NPH;
    hipLaunchKernelGGL(fwd, dim3(grid), dim3(512), LDS_BYTES, stream, a);
#else
    for (int p = 0; p < NPH; ++p) { a.ph_lo = p; a.ph_hi = p + 1; hipLaunchKernelGGL(fwd, dim3(grid), dim3(512), LDS_BYTES, stream, a); }
#endif
}
```

```cpp
#include <hip/hip_runtime.h>
#include <cstdio>
#include <cstdint>
namespace pg8 {
#define PG8_LAS __attribute__((address_space(3)))
typedef unsigned short bf16_t;
typedef short bf16x8 __attribute__((ext_vector_type(8)));
typedef float f32x4 __attribute__((ext_vector_type(4)));
typedef float f32x2 __attribute__((ext_vector_type(2)));
typedef unsigned u32x4 __attribute__((ext_vector_type(4)));
constexpr int BM = 256, BK = 64, HALF = 128, HTB = HALF * BK * 2, STAGE_BYTES = 8 * HTB, NXCD = 8, WGM = 8;
__host__ __device__ __forceinline__ int lds_byte(int r, int c) { const int st = (r >> 4) * 2 + (c >> 5), rr = r & 15, cc = c & 31, ob = rr * 64 + cc * 2; return st * 1024 + (ob ^ (((ob >> 9) & 1) << 5)); }
__host__ __device__ __forceinline__ void stage_rc(int b, int& R, int& C) { const int st = b / 1024, sb = b % 1024, swz = sb ^ (((sb >> 9) & 1) << 5); R = (st >> 1) * 16 + swz / 64; C = (st & 1) * 32 + (swz % 64) / 2; }
__host__ __device__ __forceinline__ int perm32(int rho) { const int n = rho >> 4, i = rho & 15; return 8 * (i >> 2) + 4 * n + (i & 3); }
struct Unit { int pm, pn, e; };
struct Gemm { const bf16_t* A; const bf16_t* Bt; int K; size_t bstride; };
struct TileOrder {
    int nM, nN, nwg, G, c; const PG8_LAS unsigned short* tile_e;
    __device__ void init(int nM_, int nN_, int G_, int c_, const PG8_LAS unsigned short* te) { nM = nM_; nN = nN_; nwg = nM * nN; G = G_; c = c_; tile_e = te; }
    __device__ bool next(int i, Unit& u) const {
        const long L = (long)i * G + c; if (L >= nwg) return false;
        int wgid = (int)L; { const int q = nwg / NXCD, r = nwg % NXCD, xcd = wgid % NXCD, off = wgid / NXCD; wgid = (xcd < r ? xcd * (q + 1) : r * (q + 1) + (xcd - r) * q) + off; }
        const int nig = WGM * nN, gid = wgid / nig, fm = gid * WGM, gsz = (nM - fm) < WGM ? (nM - fm) : WGM;
        u.pm = fm + ((wgid % nig) % gsz); u.pn = (wgid % nig) / gsz; u.e = tile_e ? (int)tile_e[u.pm] : 0; return true;
    }
    __device__ __forceinline__ void a_ready(const Unit&) const {}
    __device__ __forceinline__ void done(const Unit&) const {}
};
__device__ __forceinline__ unsigned cvt_pk_bf16(float lo, float hi) { unsigned r; asm volatile("v_cvt_pk_bf16_f32 %0, %1, %2" : "=v"(r) : "v"(lo), "v"(hi)); return r; }
struct EpiBf16 {
    static constexpr bool PERM = true, AFTER_DRAIN = false;
    bf16_t* O; int ldc; const float* bias; int bias_stride;
    __device__ __forceinline__ void operator()(const f32x4 (&acc)[2][2][4][2], const Unit& u, int wr, int wc, int fr, int fq) const {
        const int row0 = u.pm * BM + wr * 64 + fr; const int col0 = u.pn * BM + wc * 32 + 8 * fq;
        f32x4 bv[2][2];
#pragma unroll
        for (int bj = 0; bj < 2; ++bj)
#pragma unroll
            for (int n = 0; n < 2; ++n) bv[bj][n] = bias ? *(const f32x4*)(bias + (size_t)u.e * bias_stride + col0 + bj * HALF + 4 * n) : (f32x4){0.f, 0.f, 0.f, 0.f};
#pragma unroll
        for (int ai = 0; ai < 2; ++ai)
#pragma unroll
            for (int m = 0; m < 4; ++m) { bf16_t* rowp = O + (size_t)(row0 + ai * HALF + m * 16) * ldc + col0;
#pragma unroll
                for (int bj = 0; bj < 2; ++bj) { const f32x4 v0 = acc[ai][bj][m][0] + bv[bj][0], v1 = acc[ai][bj][m][1] + bv[bj][1];
                    u32x4 w; w.x = cvt_pk_bf16(v0[0], v0[1]); w.y = cvt_pk_bf16(v0[2], v0[3]); w.z = cvt_pk_bf16(v1[0], v1[1]); w.w = cvt_pk_bf16(v1[2], v1[3]);
                    *(u32x4*)(rowp + bj * HALF) = w; } }
    }
};
__device__ __forceinline__ float swiglu1(float g, float u) {
    g = fminf(g, 7.0f); u = fminf(fmaxf(u, -7.0f), 7.0f);
    const float sg = __builtin_amdgcn_rcpf(1.0f + __builtin_amdgcn_exp2f(g * (-1.702f * 1.44269504f)));
    return g * sg * (u + 1.0f);
}
struct EpiSwiglu {
    static constexpr bool PERM = true, AFTER_DRAIN = false;
    bf16_t* O; const float* b1;
    __device__ __forceinline__ void operator()(const f32x4 (&acc)[2][2][4][2], const Unit& u, int wr, int wc, int fr, int fq) const {
        const int row0 = u.pm * BM + wr * 64 + fr; const int col0 = u.pn * HALF + wc * 32 + 8 * fq;
        const float* bg = b1 + (size_t)u.e * 2048 + col0;
        f32x4 bgv[2], buv[2];
#pragma unroll
        for (int n = 0; n < 2; ++n) { bgv[n] = *(const f32x4*)(bg + 4 * n); buv[n] = *(const f32x4*)(bg + 1024 + 4 * n); }
#pragma unroll
        for (int ai = 0; ai < 2; ++ai)
#pragma unroll
            for (int m = 0; m < 4; ++m) { bf16_t* rowp = O + (size_t)(row0 + ai * HALF + m * 16) * 1024 + col0;
                const f32x4 g0 = acc[ai][0][m][0] + bgv[0], g1 = acc[ai][0][m][1] + bgv[1], u0 = acc[ai][1][m][0] + buv[0], u1 = acc[ai][1][m][1] + buv[1];
                u32x4 w; w.x = cvt_pk_bf16(swiglu1(g0[0], u0[0]), swiglu1(g0[1], u0[1])); w.y = cvt_pk_bf16(swiglu1(g0[2], u0[2]), swiglu1(g0[3], u0[3]));
                w.z = cvt_pk_bf16(swiglu1(g1[0], u1[0]), swiglu1(g1[1], u1[1])); w.w = cvt_pk_bf16(swiglu1(g1[2], u1[2]), swiglu1(g1[3], u1[3]));
                *(u32x4*)rowp = w; }
    }
};
template <class Epi, class Sched, bool ALIGN_EPI = false, bool SP2 = false>
__device__ __forceinline__ void gemm_phase(PG8_LAS unsigned char* lds, const Gemm g, const Sched& S, const Epi& E, const int tid_in) {
    const int tid = tid_in, wid = __builtin_amdgcn_readfirstlane(tid >> 6), lane = tid & 63, wr = wid >> 2, wc = wid & 3, fr = lane & 15, fq = lane >> 4;
    const int K = g.K, nt = K / BK;
    unsigned voffA[2], voffB[2];
#pragma unroll
    for (int i = 0; i < 2; ++i) { int R, C; stage_rc(tid * 16 + i * 8192, R, C); const int Rb = Epi::PERM ? ((R & ~31) + perm32(R & 31)) : R;
        voffA[i] = (unsigned)(R * K + C) * 2u; voffB[i] = (unsigned)(Rb * K + C) * 2u; }
    const size_t kstep = (size_t)(BK * 2);
    const size_t hstep = (size_t)HALF * K * 2;
    const size_t tstep = 2 * hstep;
    const unsigned ldsw = (unsigned)wid * 1024u;
    const int aoff = lds_byte(wr * 64 + fr, fq * 8), boff = lds_byte(wc * 32 + fr, fq * 8);
#define PG8_SA(b, h) (((b) * 2 + (h)) * HTB)
#define PG8_SB(b, h) ((4 + (b) * 2 + (h)) * HTB)
#define PG8_STAGE(bufoff, gbase, voff) do { _Pragma("unroll") for (int _i = 0; _i < 2; ++_i) \
        __builtin_amdgcn_global_load_lds((const unsigned*)((const char*)(gbase) + (voff)[_i]), (PG8_LAS unsigned*)(lds + (bufoff) + ldsw + _i * 8192), 16, 0, 0); } while (0)
#define PG8_LDA(dst, b, h) do { _Pragma("unroll") for (int m = 0; m < 4; ++m) _Pragma("unroll") for (int k = 0; k < 2; ++k) dst[m][k] = *(const PG8_LAS bf16x8*)(lds + PG8_SA(b, h) + aoff + m * 2048 + k * 1024); } while (0)
#define PG8_LDB(dst, b, h) do { _Pragma("unroll") for (int n = 0; n < 2; ++n) _Pragma("unroll") for (int k = 0; k < 2; ++k) dst[n][k] = *(const PG8_LAS bf16x8*)(lds + PG8_SB(b, h) + boff + n * 2048 + k * 1024); } while (0)
#define PG8_MMA(ai, bj, At, Bt) do { __builtin_amdgcn_s_setprio(1); _Pragma("unroll") for (int m = 0; m < 4; ++m) _Pragma("unroll") for (int n = 0; n < 2; ++n) _Pragma("unroll") for (int k = 0; k < 2; ++k) \
        acc[ai][bj][m][n] = __builtin_amdgcn_mfma_f32_16x16x32_bf16(Bt[n][k], At[m][k], acc[ai][bj][m][n], 0, 0, 0); __builtin_amdgcn_s_setprio(0); } while (0)
#define PG8_WAIT_V(n) asm volatile("s_waitcnt vmcnt(" #n ")" ::: "memory")
#define PG8_WAIT_L(n) asm volatile("s_waitcnt lgkmcnt(" #n ")" ::: "memory")
#define PG8_BAR __builtin_amdgcn_s_barrier()
#define PG8_SCHED __builtin_amdgcn_sched_barrier(0)
    Unit cur, nxt; int ui = 0;
    if (!S.next(0, cur)) return;
    f32x4 acc[2][2][4][2];
#pragma unroll
    for (int a = 0; a < 2; ++a)
#pragma unroll
        for (int b = 0; b < 2; ++b)
#pragma unroll
            for (int m = 0; m < 4; ++m)
#pragma unroll
                for (int n = 0; n < 2; ++n) acc[a][b][m][n] = (f32x4){0.f, 0.f, 0.f, 0.f};
    bf16x8 At[4][2], B0[2][2], B1[2][2];
    const char* cA = (const char*)g.A + (size_t)cur.pm * tstep; const char* cB = (const char*)g.Bt + (size_t)cur.e * g.bstride + (size_t)cur.pn * tstep;
    S.a_ready(cur);
    if constexpr (SP2) {
        PG8_STAGE(PG8_SB(0, 0), cB, voffB); PG8_STAGE(PG8_SB(0, 1), cB + hstep, voffB); PG8_STAGE(PG8_SA(0, 0), cA, voffA); PG8_STAGE(PG8_SA(0, 1), cA + hstep, voffA);
        if (wr == 1) PG8_BAR;
        PG8_WAIT_V(2); PG8_BAR;
        PG8_STAGE(PG8_SB(1, 0), cB + kstep, voffB); PG8_STAGE(PG8_SA(1, 0), cA + kstep, voffA); PG8_STAGE(PG8_SB(1, 1), cB + hstep + kstep, voffB);
        PG8_WAIT_V(6); PG8_BAR;
    } else {
        PG8_STAGE(PG8_SB(0, 0), cB, voffB); PG8_STAGE(PG8_SA(0, 0), cA, voffA); PG8_STAGE(PG8_SB(0, 1), cB + hstep, voffB); PG8_STAGE(PG8_SA(0, 1), cA + hstep, voffA);
        if (wr == 1) PG8_BAR;
        PG8_WAIT_V(4); PG8_BAR;
        PG8_STAGE(PG8_SB(1, 0), cB + kstep, voffB); PG8_STAGE(PG8_SA(1, 0), cA + kstep, voffA); PG8_STAGE(PG8_SB(1, 1), cB + hstep + kstep, voffB);
        PG8_WAIT_V(6); PG8_BAR;
    }
    for (;;) {
        const bool has_next = S.next(ui + 1, nxt);
        const char* nA = has_next ? (const char*)g.A + (size_t)nxt.pm * tstep : cA; const char* nB = has_next ? (const char*)g.Bt + (size_t)nxt.e * g.bstride + (size_t)nxt.pn * tstep : cB;
        for (int t = 0; t < nt; t += 2) {
            const bool last = (t == nt - 2);
            const char* a1 = cA + (size_t)(t + 1) * kstep;
            const char* a2 = last ? nA : cA + (size_t)(t + 2) * kstep; const char* b2 = last ? nB : cB + (size_t)(t + 2) * kstep;
            const char* a3 = a2 + kstep; const char* b3 = b2 + kstep;
            if (last && has_next) S.a_ready(nxt);
            if constexpr (SP2) {
            PG8_LDB(B0, 0, 0); PG8_LDB(B1, 0, 1); PG8_SCHED; PG8_LDA(At, 0, 0); PG8_STAGE(PG8_SA(1, 1), a1 + hstep, voffA);
            PG8_WAIT_V(8); PG8_WAIT_L(0); PG8_BAR; PG8_MMA(0, 0, At, B0); PG8_MMA(0, 1, At, B1); PG8_BAR; PG8_SCHED;
            PG8_LDA(At, 0, 1); PG8_STAGE(PG8_SB(0, 0), b2, voffB); PG8_STAGE(PG8_SB(0, 1), b2 + hstep, voffB); PG8_STAGE(PG8_SA(0, 0), a2, voffA);
            PG8_WAIT_V(8); PG8_WAIT_L(0); PG8_BAR; PG8_MMA(1, 0, At, B0); PG8_MMA(1, 1, At, B1); PG8_BAR; PG8_SCHED;
            PG8_LDB(B0, 1, 0); PG8_LDB(B1, 1, 1); PG8_SCHED; PG8_LDA(At, 1, 0); PG8_STAGE(PG8_SA(0, 1), a2 + hstep, voffA);
            PG8_WAIT_V(8); PG8_WAIT_L(0); PG8_BAR; PG8_MMA(0, 0, At, B0); PG8_MMA(0, 1, At, B1); PG8_BAR; PG8_SCHED;
            PG8_LDA(At, 1, 1); PG8_STAGE(PG8_SB(1, 0), b3, voffB); PG8_STAGE(PG8_SB(1, 1), b3 + hstep, voffB); PG8_STAGE(PG8_SA(1, 0), a3, voffA);
            PG8_WAIT_V(8); PG8_WAIT_L(0); PG8_BAR; PG8_MMA(1, 0, At, B0); PG8_MMA(1, 1, At, B1); PG8_BAR; PG8_SCHED;
            } else {
            PG8_LDB(B0, 0, 0); PG8_SCHED; PG8_LDA(At, 0, 0); PG8_STAGE(PG8_SA(1, 1), a1 + hstep, voffA);
            PG8_WAIT_L(8); PG8_BAR; PG8_WAIT_L(0); PG8_MMA(0, 0, At, B0); PG8_BAR; PG8_SCHED;
            PG8_LDB(B1, 0, 1); PG8_STAGE(PG8_SB(0, 0), b2, voffB);
            PG8_BAR; PG8_WAIT_L(0); PG8_MMA(0, 1, At, B1); PG8_BAR;
            PG8_LDA(At, 0, 1); PG8_STAGE(PG8_SA(0, 0), a2, voffA);
            PG8_BAR; PG8_WAIT_L(0); PG8_MMA(1, 0, At, B0); PG8_BAR; PG8_SCHED;
            PG8_STAGE(PG8_SB(0, 1), b2 + hstep, voffB);
            PG8_WAIT_V(6); PG8_BAR; PG8_MMA(1, 1, At, B1); PG8_BAR;
            PG8_LDB(B0, 1, 0); PG8_SCHED; PG8_LDA(At, 1, 0); PG8_STAGE(PG8_SA(0, 1), a2 + hstep, voffA);
            PG8_WAIT_L(8); PG8_BAR; PG8_WAIT_L(0); PG8_MMA(0, 0, At, B0); PG8_BAR; PG8_SCHED;
            PG8_LDB(B1, 1, 1); PG8_STAGE(PG8_SB(1, 0), b3, voffB);
            PG8_BAR; PG8_WAIT_L(0); PG8_MMA(0, 1, At, B1); PG8_BAR;
            PG8_LDA(At, 1, 1); PG8_STAGE(PG8_SA(1, 0), a3, voffA);
            PG8_BAR; PG8_WAIT_L(0); PG8_MMA(1, 0, At, B0); PG8_BAR; PG8_SCHED;
            PG8_STAGE(PG8_SB(1, 1), b3 + hstep, voffB);
            PG8_WAIT_V(6); PG8_BAR; PG8_MMA(1, 1, At, B1); PG8_BAR;
            }
        }
        if constexpr (ALIGN_EPI) { if (wr == 0) PG8_BAR; }
        if constexpr (!Epi::AFTER_DRAIN) { E(acc, cur, wr, wc, fr, fq); S.done(cur); }
        if (!has_next) break;
#pragma unroll
        for (int a = 0; a < 2; ++a)
#pragma unroll
            for (int b = 0; b < 2; ++b)
#pragma unroll
                for (int m = 0; m < 4; ++m)
#pragma unroll
                    for (int n = 0; n < 2; ++n) acc[a][b][m][n] = (f32x4){0.f, 0.f, 0.f, 0.f};
        cur = nxt; cA = nA; cB = nB; ++ui;
        if constexpr (ALIGN_EPI) { if (wr == 1) PG8_BAR; }
    }
    PG8_WAIT_V(0);
    if constexpr (!ALIGN_EPI) { if (wr == 0) PG8_BAR; }
    PG8_BAR;
    if constexpr (Epi::AFTER_DRAIN) { E.fused(acc, cur, wr, wc, fr, fq, lds, wid, lane); S.done(cur); }
#undef PG8_SA
#undef PG8_SB
#undef PG8_STAGE
#undef PG8_LDA
#undef PG8_LDB
#undef PG8_MMA
#undef PG8_WAIT_V
#undef PG8_WAIT_L
#undef PG8_BAR
#undef PG8_SCHED
}
}

#define GAS __attribute__((address_space(1)))
#define LAS __attribute__((address_space(3)))
typedef unsigned short bf16;
typedef unsigned v4u __attribute__((ext_vector_type(4)));
typedef unsigned v2u __attribute__((ext_vector_type(2)));
typedef float f32x4 __attribute__((ext_vector_type(4)));
typedef float f32x2 __attribute__((ext_vector_type(2)));
typedef short bf16x8 __attribute__((ext_vector_type(8)));
typedef short s16x4 __attribute__((ext_vector_type(4)));
typedef int v4i __attribute__((ext_vector_type(4)));
#define RLX_AGENT __ATOMIC_RELAXED, __HIP_MEMORY_SCOPE_AGENT
#define LDS_WAIT() asm volatile("s_waitcnt lgkmcnt(0)" ::: "memory")
#define VM_WAIT() asm volatile("s_waitcnt vmcnt(0)" ::: "memory")

#ifndef MK_ONE_LAUNCH
#define MK_ONE_LAUNCH 1
#endif

constexpr int BATCH = 32, SEQ = 2048, D = 1024, DEPTH = 4, T = BATCH * SEQ;
constexpr int NH = 12, HD = 64, AW = 768, LW = 256, NIN = 2816, NE = 32, TOPK = 4, DFF = 1024;
constexpr float ALPHA = 1.6817928305074292f, LN_EPS = 1e-5f, RMS_EPS = 1e-6f, LOG2E = 1.4426950408889634f;
constexpr int NSLOT_MAX = T * TOPK + NE * 256;
constexpr int NPH_LAYER = 9, NPH = 2 + DEPTH * NPH_LAYER;

constexpr size_t MiB = 1u << 20;
constexpr size_t WS_CTL = 0, CTL_ZERO_BYTES = 1 * MiB;
constexpr size_t WS_MODS = 1 * MiB, WS_TOPI = 4 * MiB, WS_TOPW = 5 * MiB, WS_SLOT = 6 * MiB, WS_WGB = 7 * MiB;
constexpr size_t WS_LSE = 8 * MiB, WS_WIN = 18 * MiB, WS_WOUT = 40 * MiB, WS_W1 = 48 * MiB, WS_W2 = 560 * MiB;
constexpr size_t WS_U = 816 * MiB, WS_QKV = 944 * MiB, WS_ATTP = 1296 * MiB, WS_LRU = 1584 * MiB, WS_MIX = 1616 * MiB;
constexpr size_t WS_X = 1744 * MiB, WS_X1 = 2000 * MiB, WS_XG = 2256 * MiB, WS_ACT = 2784 * MiB, WS_END = 3312 * MiB;
static_assert((size_t)NSLOT_MAX * D * 2 <= 528 * MiB, "slot buffers");
constexpr int CW_TMO = 0, CW_BAR = 4096, CW_QCTR = 8192, CW_ETOT = 16384;

constexpr int RING_BYTES = 131072, MISC_OFF = RING_BYTES + 1024, LDS_BYTES = RING_BYTES + 8192;
constexpr int MW_TICKET = 4, MW_HIST = 16, MW_WGB = 48, MW_EBASE = 80, MW_TILEE = 128;

__device__ __forceinline__ unsigned f2bf(float f) { unsigned u = __builtin_bit_cast(unsigned, f); return (u + 0x7fffu + ((u >> 16) & 1u)) >> 16; }
__device__ __forceinline__ unsigned pk2(float lo, float hi) { unsigned r; asm volatile("v_cvt_pk_bf16_f32 %0, %1, %2" : "=v"(r) : "v"(lo), "v"(hi)); return r; }
__device__ __forceinline__ float bf_lo(unsigned w) { return __builtin_bit_cast(float, w << 16); }
__device__ __forceinline__ float bf_hi(unsigned w) { return __builtin_bit_cast(float, w & 0xffff0000u); }
__device__ __forceinline__ float ex2(float x) { return __builtin_amdgcn_exp2f(x); }
__device__ __forceinline__ float rcp(float x) { return __builtin_amdgcn_rcpf(x); }
__device__ __forceinline__ float sigmoidf_(float x) { return rcp(1.0f + ex2(-LOG2E * x)); }

#define XB_TMO      128
#define XB_XCNT(j)  (256  + 64 * (j))
#define XB_XSUB(j)  (1280 + 64 * (j))
#define XB_XGEN(j)  (2304 + 64 * (j))
#define XB_TOP      3328
#define XB_TOPGEN   3392
#define XCD_BAR_WORDS 3456
#define XB_SPIN_CAP (1u << 18)

__device__ __forceinline__ unsigned xb_ld(unsigned* p)              { return __hip_atomic_load(p, __ATOMIC_RELAXED, __HIP_MEMORY_SCOPE_AGENT); }
__device__ __forceinline__ unsigned xb_add(unsigned* p, unsigned v) { return __hip_atomic_fetch_add(p, v, __ATOMIC_RELAXED, __HIP_MEMORY_SCOPE_AGENT); }
__device__ __forceinline__ unsigned xb_xcc_id() { return (unsigned)__builtin_amdgcn_s_getreg((3 << 11) | 20) & 0xFu; }
#define XB_SPIN(cond, bar) do { unsigned _sp = 0; while (cond) { __builtin_amdgcn_s_sleep(1); \
    if ((++_sp & 255u) == 0u) { if (xb_ld(&(bar)[XB_TMO])) break; if (_sp > XB_SPIN_CAP) { atomicAdd(&(bar)[XB_TMO], 1u); break; } } } } while (0)

struct XcdBarrier {
    unsigned* bar; unsigned x;
    volatile LAS unsigned* st;
};

__device__ __forceinline__ XcdBarrier xcd_barrier_post(unsigned* bar, volatile LAS unsigned* st) {
    XcdBarrier b; b.bar = bar; b.x = xb_xcc_id(); b.st = st;
    if (threadIdx.x == 0) (void)xb_add(&bar[XB_XCNT(b.x)], 1u);
    return b;
}
__device__ __forceinline__ void xcd_barrier_complete(unsigned* bar, unsigned x, unsigned& nloc, unsigned& nx) {
    const unsigned G = gridDim.x * gridDim.y * gridDim.z;
    unsigned sum, cnt, mine, sp = 0u;
    for (;;) {
        sum = 0u; cnt = 0u; mine = 0u;
#pragma unroll
        for (unsigned j = 0; j < 16; ++j) { const unsigned c = xb_ld(&bar[XB_XCNT(j)]); sum += c; cnt += (c > 0u) ? 1u : 0u; mine = (j == x) ? c : mine; }
        if (sum == G) break;
        __builtin_amdgcn_s_sleep(1);
        if ((++sp & 255u) == 0u) { if (xb_ld(&bar[XB_TMO])) break; if (sp > XB_SPIN_CAP) { atomicAdd(&bar[XB_TMO], 1u); break; } }
    }
    nloc = mine > 0u ? mine : 1u; nx = cnt > 0u ? cnt : 1u;
}

__device__ __forceinline__ void xcd_barrier(const XcdBarrier& b) {
    asm volatile("s_waitcnt vmcnt(0)" ::: "memory");
    __syncthreads();
    if (threadIdx.x == 0) {
        unsigned* bar = b.bar;
        __builtin_amdgcn_s_waitcnt(0);
        unsigned nloc = b.st[0], nx = b.st[1];
        if (nloc == 0u) { xcd_barrier_complete(bar, b.x, nloc, nx); b.st[0] = nloc; b.st[1] = nx; }
        const unsigned old = xb_add(&bar[XB_XSUB(b.x)], 1u);
        const unsigned gen = old / nloc;
        if (old + 1u == (gen + 1u) * nloc) {
            __builtin_amdgcn_fence(__ATOMIC_RELEASE, "agent");
            asm volatile("s_waitcnt vmcnt(0)" ::: "memory");
            const unsigned og = xb_add(&bar[XB_TOP], 1u);
            const unsigned tg = og / nx;
            if (og + 1u == (tg + 1u) * nx) xb_add(&bar[XB_TOPGEN], 1u);
            else XB_SPIN(xb_ld(&bar[XB_TOPGEN]) == tg, bar);
            __builtin_amdgcn_fence(__ATOMIC_ACQUIRE, "agent");
            xb_add(&bar[XB_XGEN(b.x)], 1u);
            asm volatile("s_waitcnt vmcnt(0)" ::: "memory");
        } else {
            XB_SPIN(xb_ld(&bar[XB_XGEN(b.x)]) == gen, bar);
            __builtin_amdgcn_fence(__ATOMIC_ACQUIRE, "agent");
            asm volatile("s_waitcnt vmcnt(0)" ::: "memory");
        }
    }
    __syncthreads();
}

__device__ __forceinline__ float wave_sum(float v) {
#pragma unroll
    for (int o = 1; o < 64; o <<= 1) v += __shfl_xor(v, o);
    return v;
}
__device__ __forceinline__ float wave_max(float v) {
#pragma unroll
    for (int o = 1; o < 64; o <<= 1) v = fmaxf(v, __shfl_xor(v, o));
    return v;
}

struct Args { const float* in[25]; float* out; unsigned char* ws; int ph_lo, ph_hi; };
enum { I_X = 0, I_C, I_WCOND, I_BCOND, I_WIN, I_CONVW, I_CONVB, I_WA, I_BA, I_WX, I_BX, I_LAM, I_ANG, I_LNG, I_WOUT, I_LN1G, I_LN1B, I_RW, I_RB, I_W1, I_B1, I_W2, I_B2, I_LN2G, I_LN2B };

__device__ __forceinline__ void cvt_item(const float* W, int N, bf16* WTrow0, int k0, int n0, LAS float* scr, int lane) {
    f32x4 v[8];
#pragma unroll
    for (int i = 0; i < 8; ++i) { const int kk = 4 * i + (lane >> 4); v[i] = *(const GAS f32x4*)(W + (size_t)(k0 + kk) * N + n0 + 4 * (lane & 15)); }
#pragma unroll
    for (int i = 0; i < 8; ++i) { const int kk = 4 * i + (lane >> 4); LAS float* p = scr + kk * 65 + 4 * (lane & 15); p[0] = v[i][0]; p[1] = v[i][1]; p[2] = v[i][2]; p[3] = v[i][3]; }
    LDS_WAIT(); asm volatile("" ::: "memory");
#pragma unroll
    for (int j = 0; j < 4; ++j) { const int idx = lane + 64 * j, n = idx >> 2, c = idx & 3; const LAS float* s = scr + (8 * c) * 65 + n;
        v4u o; o.x = pk2(s[0 * 65], s[1 * 65]); o.y = pk2(s[2 * 65], s[3 * 65]); o.z = pk2(s[4 * 65], s[5 * 65]); o.w = pk2(s[6 * 65], s[7 * 65]);
        *(GAS v4u*)(WTrow0 + (size_t)n * D + k0 + 8 * c) = o; }
    LDS_WAIT(); asm volatile("" ::: "memory");
}
__device__ __forceinline__ void p0_convert(const Args& a, LAS unsigned char* lds, int gw, int NGW, int wave, int lane) {
    LAS float* scr = (LAS float*)(lds + wave * 8448);
    bf16* WIN = (bf16*)(a.ws + WS_WIN); bf16* WOUT = (bf16*)(a.ws + WS_WOUT); bf16* W1 = (bf16*)(a.ws + WS_W1); bf16* W2 = (bf16*)(a.ws + WS_W2);
    constexpr int KB = D / 32;
    constexpr int I_IN1 = KB * (NIN / 64), I_OUT1 = KB * (D / 64), I_W11 = KB * (2 * DFF / 64), I_W21 = KB * (D / 64);
    constexpr int N_IN = DEPTH * I_IN1, N_OUT = DEPTH * I_OUT1, N_W1 = DEPTH * NE * I_W11, N_W2 = DEPTH * NE * I_W21;
    for (int it = gw; it < N_IN + N_OUT + N_W1 + N_W2; it += NGW) {
        int r = it;
        if (r < N_IN) { const int l = r / I_IN1, q = r % I_IN1, nb = q / KB, kb = q % KB;
            cvt_item(a.in[I_WIN] + (size_t)l * D * NIN, NIN, WIN + (size_t)l * NIN * D + (size_t)(64 * nb) * D, 32 * kb, 64 * nb, scr, lane); continue; }
        r -= N_IN;
        if (r < N_OUT) { const int l = r / I_OUT1, q = r % I_OUT1, nb = q / KB, kb = q % KB;
            cvt_item(a.in[I_WOUT] + (size_t)l * D * D, D, WOUT + (size_t)l * D * D + (size_t)(64 * nb) * D, 32 * kb, 64 * nb, scr, lane); continue; }
        r -= N_OUT;
        if (r < N_W1) { const int le = r / I_W11, q = r % I_W11, nb = q / KB, kb = q % KB; const int n0 = 64 * nb;
            const int orow = n0 < DFF ? 256 * (n0 >> 7) + (n0 & 127) : 256 * ((n0 - DFF) >> 7) + 128 + ((n0 - DFF) & 127);
            cvt_item(a.in[I_W1] + (size_t)le * D * 2 * DFF, 2 * DFF, W1 + (size_t)le * 2 * DFF * D + (size_t)orow * D, 32 * kb, n0, scr, lane); continue; }
        r -= N_W1;
        { const int le = r / I_W21, q = r % I_W21, nb = q / KB, kb = q % KB;
            cvt_item(a.in[I_W2] + (size_t)le * DFF * D, D, W2 + (size_t)le * D * DFF + (size_t)(64 * nb) * DFF, 32 * kb, 64 * nb, scr, lane); }
    }
}
__device__ __forceinline__ void p0_mods(const Args& a, LAS unsigned char* lds, int wg, int G, int wave, int lane, int tid) {
    LAS float* sc = (LAS float*)lds;
    for (int i = tid; i < BATCH * D; i += 512) { const float x = a.in[I_C][i]; sc[i] = x * sigmoidf_(x); }
    __syncthreads();
    float* mods = (float*)(a.ws + WS_MODS);
    constexpr int NCH = DEPTH * 6 * D / 64;
    for (int ch = wg; ch < NCH; ch += G) {
        const int l = ch / (6 * D / 64), col = (ch % (6 * D / 64)) * 64 + lane;
        const float* w = a.in[I_WCOND] + (size_t)l * D * 6 * D + col;
        float acc[4] = {0.f, 0.f, 0.f, 0.f};
        const LAS float* s0 = sc + (4 * wave) * D;
        for (int d0 = 0; d0 < D; d0 += 4) {
            float wv[4];
#pragma unroll
            for (int j = 0; j < 4; ++j) wv[j] = *(const GAS float*)(w + (size_t)(d0 + j) * 6 * D);
#pragma unroll
            for (int bb = 0; bb < 4; ++bb) { const f32x4 s = *(const LAS f32x4*)(s0 + bb * D + d0); acc[bb] += s[0] * wv[0] + s[1] * wv[1] + s[2] * wv[2] + s[3] * wv[3]; }
        }
        const float bc = a.in[I_BCOND][l * 6 * D + col];
#pragma unroll
        for (int bb = 0; bb < 4; ++bb) mods[((size_t)l * BATCH + 4 * wave + bb) * 6 * D + col] = acc[bb] + bc;
    }
    __syncthreads();
}

__device__ __forceinline__ void ln_stats(const f32x4 (&v)[4], float& mean, float& rstd) {
    float s = 0.f;
#pragma unroll
    for (int j = 0; j < 4; ++j) s += (v[j][0] + v[j][1]) + (v[j][2] + v[j][3]);
    mean = wave_sum(s) * (1.f / D); float q = 0.f;
#pragma unroll
    for (int j = 0; j < 4; ++j) { const f32x4 d = v[j] - mean; q += (d[0] * d[0] + d[1] * d[1]) + (d[2] * d[2] + d[3] * d[3]); }
    rstd = rsqrtf(wave_sum(q) * (1.f / D) + LN_EPS);
}
__device__ __forceinline__ void load_row4(const float* p, int lane, f32x4 (&v)[4]) {
#pragma unroll
    for (int j = 0; j < 4; ++j) v[j] = *(const GAS f32x4*)(p + 4 * lane + 256 * j);
}
__device__ __forceinline__ void store_row_bf16(bf16* p, int lane, const f32x4 (&v)[4]) {
#pragma unroll
    for (int j = 0; j < 4; ++j) { v2u o; o.x = pk2(v[j][0], v[j][1]); o.y = pk2(v[j][2], v[j][3]); *(GAS v2u*)(p + 4 * lane + 256 * j) = o; }
}
__device__ __forceinline__ void mod_ln_row(const f32x4 (&x)[4], const float* sh, const float* sc, int lane, f32x4 (&u)[4]) {
    float mean, rstd; ln_stats(x, mean, rstd);
#pragma unroll
    for (int j = 0; j < 4; ++j) { const f32x4 s1 = *(const GAS f32x4*)(sc + 4 * lane + 256 * j), s0 = *(const GAS f32x4*)(sh + 4 * lane + 256 * j); u[j] = (x[j] - mean) * rstd * (1.0f + s1) + s0; }
}
__device__ __forceinline__ void p_r0(const Args& a, int gw, int NGW, int lane) {
    const float* mods = (const float*)(a.ws + WS_MODS); bf16* U = (bf16*)(a.ws + WS_U);
    for (int t = gw; t < T; t += NGW) { const int b = t / SEQ; const float* mb = mods + (size_t)b * 6 * D;
        f32x4 x[4], u[4]; load_row4(a.in[I_X] + (size_t)t * D, lane, x); mod_ln_row(x, mb, mb + D, lane, u); store_row_bf16(U + (size_t)t * D, lane, u); }
}

namespace att {
constexpr float C1 = 0.125f * 1.4426950408889634f;
typedef short v4i16_t __attribute__((ext_vector_type(4)));
__device__ __forceinline__ s16x4 vtr(const LAS unsigned char* p) { return __builtin_bit_cast(s16x4, __builtin_amdgcn_ds_read_tr16_b64_v4i16((LAS v4i16_t*)p)); }
__device__ __forceinline__ void stage(LAS unsigned char* buf, const bf16* qkv, int b, int h, int dil, int res, int n0, int wave, int lane) {
#pragma unroll
    for (int i = 0; i < 4; ++i) {
        const int blk8 = 4 * wave + i;
        if (n0 == 0 && blk8 < 16) continue;
        const int kk = 8 * blk8 + (lane >> 3), pos = lane & 7;
        const int t = res + dil * (n0 - 128 + kk);
        const char* rowp = (const char*)qkv + ((size_t)(b * SEQ + t) * NIN + AW + h * HD) * 2;
        const int cK = pos ^ ((kk >> 1) & 7), cV = pos ^ (((kk >> 1) & 3) << 1);
        __builtin_amdgcn_global_load_lds((const unsigned*)(rowp + cK * 16), (LAS unsigned*)(buf + blk8 * 1024), 16, 0, 0);
        __builtin_amdgcn_global_load_lds((const unsigned*)(rowp + AW * 2 + cV * 16), (LAS unsigned*)(buf + 32768 + blk8 * 1024), 16, 0, 0);
    }
}
__device__ __forceinline__ void load_q(const bf16* qkv, int b, int h, int dil, int res, int n0, int wave, int lane, bf16x8 (&qf)[2]) {
    const int fr = lane & 15, fq = lane >> 4;
    const size_t trow = (size_t)(b * SEQ + res + dil * (n0 + 16 * wave + fr));
    const bf16* qrow = qkv + trow * NIN + h * HD;
#pragma unroll
    for (int s = 0; s < 2; ++s) qf[s] = *(const GAS bf16x8*)(qrow + 32 * s + 8 * fq);
}
__device__ __forceinline__ void block(const LAS unsigned char* buf, const bf16x8 (&qf)[2], bf16* outp, float* lsep, int b, int h, int dil, int res, int n0, float slope2, int wave, int lane) {
    const int fr = lane & 15, fq = lane >> 4;
    const int qi = 16 * wave + fr;
    const size_t trow = (size_t)(b * SEQ + res + dil * (n0 + qi));
    f32x4 o[4];
#pragma unroll
    for (int mt = 0; mt < 4; ++mt) o[mt] = (f32x4){0.f, 0.f, 0.f, 0.f};
    float m = -1e30f, l = 0.f;
    const int kt_lo = (n0 == 0) ? 4 : (wave >> 1), kt_hi = (16 * wave + 143) >> 5;
    for (int kt = kt_lo; kt <= kt_hi; ++kt) {
        f32x4 s[2];
#pragma unroll
        for (int sub = 0; sub < 2; ++sub) {
            const int kk = 32 * kt + 16 * sub + fr; const LAS unsigned char* kp = buf + kk * 128; const int sw = (kk >> 1) & 7;
            const bf16x8 k0 = *(const LAS bf16x8*)(kp + ((fq ^ sw) << 4)), k1 = *(const LAS bf16x8*)(kp + (((4 + fq) ^ sw) << 4));
            f32x4 z = (f32x4){0.f, 0.f, 0.f, 0.f};
            z = __builtin_amdgcn_mfma_f32_16x16x32_bf16(k0, qf[0], z, 0, 0, 0);
            s[sub] = __builtin_amdgcn_mfma_f32_16x16x32_bf16(k1, qf[1], z, 0, 0, 0);
        }
        const int dbase = qi + 128 - 32 * kt - 4 * fq;
        float p[2][4]; float mx = -1e30f;
#pragma unroll
        for (int sub = 0; sub < 2; ++sub)
#pragma unroll
            for (int r = 0; r < 4; ++r) { const int d = dbase - 16 * sub - r; const float v = ((unsigned)d <= 128u) ? (s[sub][r] * C1 - slope2 * (float)d) : -1e30f; p[sub][r] = v; mx = fmaxf(mx, v); }
        mx = fmaxf(mx, __shfl_xor(mx, 16)); mx = fmaxf(mx, __shfl_xor(mx, 32));
        const float mn = fmaxf(m, mx), alpha = ex2(m - mn); m = mn;
        float rs = 0.f;
#pragma unroll
        for (int sub = 0; sub < 2; ++sub)
#pragma unroll
            for (int r = 0; r < 4; ++r) { p[sub][r] = ex2(p[sub][r] - mn); rs += p[sub][r]; }
        l = l * alpha + rs;
        v4u pw; pw.x = pk2(p[0][0], p[0][1]); pw.y = pk2(p[0][2], p[0][3]); pw.z = pk2(p[1][0], p[1][1]); pw.w = pk2(p[1][2], p[1][3]);
        const bf16x8 pf = __builtin_bit_cast(bf16x8, pw);
        const int q4 = fr >> 2, pp = fr & 3;
#pragma unroll
        for (int mt = 0; mt < 4; ++mt) {
            const int key0 = 32 * kt + 4 * fq + q4, key1 = key0 + 16, c = 2 * mt + (pp >> 1);
            const s16x4 lo = vtr(buf + 32768 + key0 * 128 + ((c ^ (((key0 >> 1) & 3) << 1)) << 4) + 8 * (pp & 1));
            const s16x4 hi = vtr(buf + 32768 + key1 * 128 + ((c ^ (((key1 >> 1) & 3) << 1)) << 4) + 8 * (pp & 1));
            const bf16x8 vf = __builtin_shufflevector(lo, hi, 0, 1, 2, 3, 4, 5, 6, 7);
            o[mt] = __builtin_amdgcn_mfma_f32_16x16x32_bf16(vf, pf, o[mt] * alpha, 0, 0, 0);
        }
    }
    l += __shfl_xor(l, 16); l += __shfl_xor(l, 32);
    const float inv = 1.0f / l;
    bf16* orow = outp + trow * AW + h * HD + 4 * fq;
#pragma unroll
    for (int mt = 0; mt < 4; ++mt) { v2u w; w.x = pk2(o[mt][0] * inv, o[mt][1] * inv); w.y = pk2(o[mt][2] * inv, o[mt][3] * inv); *(GAS v2u*)(orow + 16 * mt) = w; }
    if (fq == 0) lsep[trow * NH + h] = m + __builtin_amdgcn_logf(l);
}
__device__ __forceinline__ void ticket(LAS unsigned char* lds, const Args& a, int tk, int wave, int lane) {
    const bf16* qkv = (const bf16*)(a.ws + WS_QKV);
    const int bh = tk / 6, rem = tk % 6, patt = rem >> 1, half = rem & 1, b = bh / NH, h = bh % NH;
    const int dil = patt == 0 ? 1 : (patt == 1 ? 4 : 16);
    const float slope = h < 8 ? exp2f(-(float)(h + 1)) : exp2f(-(0.5f + (float)(h - 8)));
    const float slope2 = slope * (float)dil * LOG2E;
    bf16* outp = (bf16*)(a.ws + WS_ATTP) + (size_t)patt * T * AW; float* lsep = (float*)(a.ws + WS_LSE) + (size_t)patt * T * NH;
    int res, qb;
#define ATT_DESC(j) do { if (patt == 0) { res = 0; qb = 8 * half + (j); } else if (patt == 1) { res = 2 * half + ((j) >> 2); qb = (j) & 3; } else { res = 8 * half + (j); qb = 0; } } while (0)
    ATT_DESC(0); stage(lds, qkv, b, h, dil, res, 128 * qb, wave, lane);
    for (int j = 0; j < 8; ++j) {
        VM_WAIT(); __syncthreads();
        ATT_DESC(j); const int res_j = res, n0_j = 128 * qb;
        bf16x8 qf[2]; load_q(qkv, b, h, dil, res_j, n0_j, wave, lane, qf);
        if (j + 1 < 8) { ATT_DESC(j + 1); stage(lds + ((j + 1) & 1) * 65536, qkv, b, h, dil, res, 128 * qb, wave, lane); }
        block(lds + (j & 1) * 65536, qf, outp, lsep, b, h, dil, res_j, n0_j, slope2, wave, lane);
    }
#undef ATT_DESC
}
}
namespace lru {
constexpr int XC_OFF = 0, XCF_OFF = 16384, XG_OFF = XCF_OFF + 128 * 68 * 4, OUT_OFF = XG_OFF + 128 * 72 * 2, AGG_OFF = OUT_OFF + 128 * 72 * 2, WF_OFF = AGG_OFF + 4096;
static_assert(WF_OFF + 16384 <= RING_BYTES, "lru lds");
__device__ __forceinline__ void unit(LAS unsigned char* lds, const Args& a, int l, int tk, int wave, int lane, int tid) {
    const int b = tk >> 2, blk = tk & 3, fr = lane & 15, fq = lane >> 4;
    const bf16* qkv = (const bf16*)(a.ws + WS_QKV); bf16* outg = (bf16*)(a.ws + WS_LRU);
    LAS v4u* WF = (LAS v4u*)(lds + WF_OFF);
    {
#pragma unroll
      for (int ff = 0; ff < 2; ++ff) { const int f = 2 * wave + ff, gate = f >> 3, nt = (f >> 1) & 3, s = f & 1;
        const float* W = (gate ? a.in[I_WX] : a.in[I_WA]) + ((size_t)l * 4 + blk) * 64 * 64;
        const int k0 = 32 * s + 8 * fq, oc = 16 * nt + fr; v4u pa;
        pa.x = pk2(W[(k0 + 0) * 64 + oc], W[(k0 + 1) * 64 + oc]); pa.y = pk2(W[(k0 + 2) * 64 + oc], W[(k0 + 3) * 64 + oc]); pa.z = pk2(W[(k0 + 4) * 64 + oc], W[(k0 + 5) * 64 + oc]); pa.w = pk2(W[(k0 + 6) * 64 + oc], W[(k0 + 7) * 64 + oc]);
        WF[f * 64 + lane] = pa; } }
    float ba[4], bx[4], csp[4], carry[4];
#pragma unroll
    for (int nt = 0; nt < 4; ++nt) { const int ch = l * LW + 64 * blk + 16 * nt + fr; ba[nt] = a.in[I_BA][ch]; bx[nt] = a.in[I_BX][ch]; csp[nt] = 8.0f * log1pf(expf(-a.in[I_LAM][ch])); carry[nt] = 0.f; }
    const int c8 = tid & 7, chb = 64 * blk + 8 * c8;
    LAS unsigned char* XC = lds + XC_OFF; LAS float* XCF = (LAS float*)(lds + XCF_OFF); LAS bf16* XG = (LAS bf16*)(lds + XG_OFF); LAS bf16* OUT = (LAS bf16*)(lds + OUT_OFF); LAS float* AGG = (LAS float*)(lds + AGG_OFF);
    for (int tile = 0; tile < 16; ++tile) {
#pragma unroll
        for (int it = 0; it < 2; ++it) {
            const int ti = (tid >> 3) + 64 * it, s = 128 * tile + ti;
            const bf16* rowp = qkv + (size_t)(b * SEQ + s) * NIN + 2304 + chb;
            float xc[8];
#pragma unroll
            for (int e = 0; e < 8; ++e) xc[e] = a.in[I_CONVB][l * LW + chb + e];
#pragma unroll
            for (int j = 0; j < 4; ++j) { const int sp = s - 3 + j; v4u xr = (v4u){0u, 0u, 0u, 0u}; if (sp >= 0) xr = *(const GAS v4u*)(rowp - (size_t)(3 - j) * NIN);
                const float* cw = a.in[I_CONVW] + ((size_t)l * 4 + j) * LW + chb;
                xc[0] += cw[0] * bf_lo(xr.x); xc[1] += cw[1] * bf_hi(xr.x); xc[2] += cw[2] * bf_lo(xr.y); xc[3] += cw[3] * bf_hi(xr.y);
                xc[4] += cw[4] * bf_lo(xr.z); xc[5] += cw[5] * bf_hi(xr.z); xc[6] += cw[6] * bf_lo(xr.w); xc[7] += cw[7] * bf_hi(xr.w); }
            v4u xb; xb.x = pk2(xc[0], xc[1]); xb.y = pk2(xc[2], xc[3]); xb.z = pk2(xc[4], xc[5]); xb.w = pk2(xc[6], xc[7]);
            *(LAS v4u*)(XC + ti * 128 + ((c8 ^ ((ti >> 1) & 7)) << 4)) = xb;
            *(LAS f32x4*)(XCF + ti * 68 + 8 * c8) = (f32x4){xc[0], xc[1], xc[2], xc[3]}; *(LAS f32x4*)(XCF + ti * 68 + 8 * c8 + 4) = (f32x4){xc[4], xc[5], xc[6], xc[7]};
            *(LAS v4u*)(XG + ti * 72 + 8 * c8) = *(const GAS v4u*)(rowp + LW);
        }
        __syncthreads();
        f32x4 ga[4], gx[4];
        { const int tok = 16 * wave + fr, sw = (tok >> 1) & 7;
          const bf16x8 a0 = *(const LAS bf16x8*)(XC + tok * 128 + ((fq ^ sw) << 4)), a1 = *(const LAS bf16x8*)(XC + tok * 128 + (((4 + fq) ^ sw) << 4));
#pragma unroll
          for (int nt = 0; nt < 4; ++nt) { f32x4 z = (f32x4){0.f, 0.f, 0.f, 0.f};
              const bf16x8 wa0 = __builtin_bit_cast(bf16x8, WF[(nt * 2 + 0) * 64 + lane]), wa1 = __builtin_bit_cast(bf16x8, WF[(nt * 2 + 1) * 64 + lane]);
              const bf16x8 wx0 = __builtin_bit_cast(bf16x8, WF[(8 + nt * 2 + 0) * 64 + lane]), wx1 = __builtin_bit_cast(bf16x8, WF[(8 + nt * 2 + 1) * 64 + lane]);
              ga[nt] = __builtin_amdgcn_mfma_f32_16x16x32_bf16(a1, wa1, __builtin_amdgcn_mfma_f32_16x16x32_bf16(a0, wa0, z, 0, 0, 0), 0, 0, 0);
              gx[nt] = __builtin_amdgcn_mfma_f32_16x16x32_bf16(a1, wx1, __builtin_amdgcn_mfma_f32_16x16x32_bf16(a0, wx0, z, 0, 0, 0), 0, 0, 0); } }
        float av[4][4], bv[4][4], Aex[4], Hex[4];
#pragma unroll
        for (int nt = 0; nt < 4; ++nt) {
            const int ch = 16 * nt + fr; float A4 = 1.f, H4 = 0.f;
#pragma unroll
            for (int r = 0; r < 4; ++r) { const int tok2 = 16 * wave + 4 * fq + r;
                const float rg = sigmoidf_(ga[nt][r] + ba[nt]), ig = sigmoidf_(gx[nt][r] + bx[nt]);
                const float la = -csp[nt] * rg, x2 = 2.0f * la, aa = ex2(la * LOG2E);
                const float ser = -x2 * (1.0f + x2 * (0.5f + x2 * (0.16666667f + x2 * (0.041666668f + x2 * 0.0083333338f))));
                const float om = (x2 > -0.3f) ? ser : (1.0f - aa * aa);
                const float bb = sqrtf(om) * ig * XCF[tok2 * 68 + ch];
                av[nt][r] = aa; bv[nt][r] = bb; H4 = aa * H4 + bb; A4 *= aa; }
            float Ap = __shfl_up(A4, 16), Hp = __shfl_up(H4, 16); if (fq >= 1) { H4 = A4 * Hp + H4; A4 = A4 * Ap; }
            Ap = __shfl_up(A4, 32); Hp = __shfl_up(H4, 32); if (fq >= 2) { H4 = A4 * Hp + H4; A4 = A4 * Ap; }
            Aex[nt] = __shfl_up(A4, 16); Hex[nt] = __shfl_up(H4, 16); if (fq == 0) { Aex[nt] = 1.f; Hex[nt] = 0.f; }
            if (fq == 3) { AGG[(wave * 64 + ch) * 2] = A4; AGG[(wave * 64 + ch) * 2 + 1] = H4; }
        }
        __syncthreads();
#pragma unroll
        for (int nt = 0; nt < 4; ++nt) {
            const int ch = 16 * nt + fr; float h = carry[nt], hw = carry[nt];
#pragma unroll
            for (int w2 = 0; w2 < 8; ++w2) { if (w2 == wave) hw = h; const float A = AGG[(w2 * 64 + ch) * 2], H = AGG[(w2 * 64 + ch) * 2 + 1]; h = A * h + H; }
            carry[nt] = h;
            float hl = Aex[nt] * hw + Hex[nt];
#pragma unroll
            for (int r = 0; r < 4; ++r) { const int tok2 = 16 * wave + 4 * fq + r; hl = av[nt][r] * hl + bv[nt][r];
                const float g = __builtin_bit_cast(float, (unsigned)XG[tok2 * 72 + ch] << 16);
                const float y = hl * g * sigmoidf_(1.5957691216f * (g + 0.044715f * g * g * g));
                OUT[tok2 * 72 + ch] = (bf16)f2bf(y); }
        }
        __syncthreads();
#pragma unroll
        for (int it = 0; it < 2; ++it) { const int ti = (tid >> 3) + 64 * it, s = 128 * tile + ti;
            *(GAS v4u*)(outg + (size_t)(b * SEQ + s) * LW + chb) = *(const LAS v4u*)(OUT + ti * 72 + 8 * c8); }
    }
}
}

__device__ __forceinline__ void merge_chunk(const bf16* ATTP, const float* LSE, int t, int c, float (&v)[8]) {
    const int head = c >> 3;
    const float l0 = LSE[(size_t)t * NH + head], l1 = LSE[(size_t)T * NH + (size_t)t * NH + head], l2 = LSE[(size_t)2 * T * NH + (size_t)t * NH + head];
    const float mx = fmaxf(l0, fmaxf(l1, l2)); float w0 = ex2(l0 - mx), w1 = ex2(l1 - mx), w2 = ex2(l2 - mx); const float inv = 1.0f / (w0 + w1 + w2); w0 *= inv; w1 *= inv; w2 *= inv;
    const v4u p0 = *(const GAS v4u*)(ATTP + (size_t)t * AW + 8 * c), p1 = *(const GAS v4u*)(ATTP + (size_t)T * AW + (size_t)t * AW + 8 * c), p2 = *(const GAS v4u*)(ATTP + (size_t)2 * T * AW + (size_t)t * AW + 8 * c);
    v[0] = w0 * bf_lo(p0.x) + w1 * bf_lo(p1.x) + w2 * bf_lo(p2.x); v[1] = w0 * bf_hi(p0.x) + w1 * bf_hi(p1.x) + w2 * bf_hi(p2.x);
    v[2] = w0 * bf_lo(p0.y) + w1 * bf_lo(p1.y) + w2 * bf_lo(p2.y); v[3] = w0 * bf_hi(p0.y) + w1 * bf_hi(p1.y) + w2 * bf_hi(p2.y);
    v[4] = w0 * bf_lo(p0.z) + w1 * bf_lo(p1.z) + w2 * bf_lo(p2.z); v[5] = w0 * bf_hi(p0.z) + w1 * bf_hi(p1.z) + w2 * bf_hi(p2.z);
    v[6] = w0 * bf_lo(p0.w) + w1 * bf_lo(p1.w) + w2 * bf_lo(p2.w); v[7] = w0 * bf_hi(p0.w) + w1 * bf_hi(p1.w) + w2 * bf_hi(p2.w);
}
__device__ __forceinline__ void p_merge(const Args& a, int l, int gw, int NGW, int lane) {
    const bf16* ATTP = (const bf16*)(a.ws + WS_ATTP); const float* LSE = (const float*)(a.ws + WS_LSE); const bf16* LRU = (const bf16*)(a.ws + WS_LRU); bf16* A2 = (bf16*)(a.ws + WS_U);
    const float* ang = a.in[I_ANG] + l * AW; const float* lng = a.in[I_LNG] + l * LW;
    const bool at1 = lane < 32;
    for (int t = gw; t < T; t += NGW) {
        float v0[8], v1[8];
        merge_chunk(ATTP, LSE, t, lane, v0);
        if (at1) merge_chunk(ATTP, LSE, t, 64 + lane, v1);
        else { const v4u p = *(const GAS v4u*)(LRU + (size_t)t * LW + 8 * (lane - 32)); v1[0] = bf_lo(p.x); v1[1] = bf_hi(p.x); v1[2] = bf_lo(p.y); v1[3] = bf_hi(p.y); v1[4] = bf_lo(p.z); v1[5] = bf_hi(p.z); v1[6] = bf_lo(p.w); v1[7] = bf_hi(p.w); }
        float s0 = 0.f, s1 = 0.f;
#pragma unroll
        for (int e = 0; e < 8; ++e) { s0 += v0[e] * v0[e]; s1 += v1[e] * v1[e]; }
        const float ssa = wave_sum(s0 + (at1 ? s1 : 0.f)), ssl = wave_sum(at1 ? 0.f : s1);
        const float ra = rsqrtf(ssa * (1.0f / AW) + RMS_EPS), rl = rsqrtf(ssl * (1.0f / LW) + RMS_EPS);
        const float* g0 = ang + 8 * lane; const float* g1 = at1 ? ang + 512 + 8 * lane : lng + 8 * (lane - 32); const float r1 = at1 ? ra : rl;
        v4u o0, o1;
        o0.x = pk2(v0[0] * ra * g0[0], v0[1] * ra * g0[1]); o0.y = pk2(v0[2] * ra * g0[2], v0[3] * ra * g0[3]); o0.z = pk2(v0[4] * ra * g0[4], v0[5] * ra * g0[5]); o0.w = pk2(v0[6] * ra * g0[6], v0[7] * ra * g0[7]);
        o1.x = pk2(v1[0] * r1 * g1[0], v1[1] * r1 * g1[1]); o1.y = pk2(v1[2] * r1 * g1[2], v1[3] * r1 * g1[3]); o1.z = pk2(v1[4] * r1 * g1[4], v1[5] * r1 * g1[5]); o1.w = pk2(v1[6] * r1 * g1[6], v1[7] * r1 * g1[7]);
        *(GAS v4u*)(A2 + (size_t)t * D + 8 * lane) = o0; *(GAS v4u*)(A2 + (size_t)t * D + 512 + 8 * lane) = o1;
    }
}

constexpr int RWP = 1028;
__device__ __forceinline__ void p_r2(const Args& a, LAS unsigned char* lds, volatile LAS unsigned* MISC, int l, int wg, int G, int wave, int lane, int tid) {
    LAS float* rwT = (LAS float*)lds;
    { const float* rw = a.in[I_RW] + (size_t)l * D * NE;
      for (int i = tid; i < D * NE; i += 512) rwT[(i & 31) * RWP + (i >> 5)] = rw[i]; }
    const float* mods = (const float*)(a.ws + WS_MODS); const float* xin = l == 0 ? a.in[I_X] : (const float*)(a.ws + WS_X);
    const bf16* MIX = (const bf16*)(a.ws + WS_MIX); float* X1 = (float*)(a.ws + WS_X1); bf16* U = (bf16*)(a.ws + WS_U);
    int* TOPI = (int*)(a.ws + WS_TOPI); float* TOPW = (float*)(a.ws + WS_TOPW); unsigned* WGB = (unsigned*)(a.ws + WS_WGB);
    unsigned* etot = (unsigned*)(a.ws + WS_CTL) + CW_ETOT + 64 * l;
    const float* l1g = a.in[I_LN1G] + l * D; const float* l1b = a.in[I_LN1B] + l * D; const float rbias = a.in[I_RB][l * NE + ((lane >> 1) & 31)];
    for (int chunk = wg; chunk < T / 256; chunk += G) {
        if (tid < 32) MISC[MW_HIST + tid] = 0u;
        __syncthreads();
        for (int i = 0; i < 32; ++i) {
            const int t = 256 * chunk + 32 * wave + i, b = t / SEQ; const float* mb = mods + ((size_t)l * BATCH + b) * 6 * D;
            f32x4 x[4], u[4]; load_row4(xin + (size_t)t * D, lane, x);
#pragma unroll
            for (int j = 0; j < 4; ++j) { const v2u mw = *(const GAS v2u*)(MIX + (size_t)t * D + 4 * lane + 256 * j); const f32x4 g1 = *(const GAS f32x4*)(mb + 2 * D + 4 * lane + 256 * j);
                const f32x4 mx = (f32x4){bf_lo(mw.x), bf_hi(mw.x), bf_lo(mw.y), bf_hi(mw.y)}; x[j] = ALPHA * x[j] + (1.0f + g1) * mx; }
            float mean, rstd; ln_stats(x, mean, rstd);
#pragma unroll
            for (int j = 0; j < 4; ++j) { const f32x4 g = *(const GAS f32x4*)(l1g + 4 * lane + 256 * j), bb = *(const GAS f32x4*)(l1b + 4 * lane + 256 * j); x[j] = (x[j] - mean) * rstd * g + bb;
                *(GAS f32x4*)(X1 + (size_t)t * D + 4 * lane + 256 * j) = x[j]; }
            mod_ln_row(x, mb + 3 * D, mb + 4 * D, lane, u);
            store_row_bf16(U + (size_t)t * D, lane, u);
            float pl[32];
#pragma unroll
            for (int e = 0; e < 32; ++e) { f32x2 acc = (f32x2){0.f, 0.f};
#pragma unroll
                for (int j = 0; j < 4; ++j) { const f32x4 w = *(const LAS f32x4*)(rwT + e * RWP + 4 * lane + 256 * j); acc += (f32x2){w[0], w[1]} * (f32x2){u[j][0], u[j][1]}; acc += (f32x2){w[2], w[3]} * (f32x2){u[j][2], u[j][3]}; }
                pl[e] = acc[0] + acc[1]; }
            float q16[16], q8[8], q4[4], q2[2], lg;
            { const bool hi = (lane & 32) != 0;
#pragma unroll
              for (int k = 0; k < 16; ++k) { const float mine = hi ? pl[16 + k] : pl[k], send = hi ? pl[k] : pl[16 + k]; q16[k] = mine + __shfl_xor(send, 32); } }
            { const bool hi = (lane & 16) != 0;
#pragma unroll
              for (int k = 0; k < 8; ++k) { const float mine = hi ? q16[8 + k] : q16[k], send = hi ? q16[k] : q16[8 + k]; q8[k] = mine + __shfl_xor(send, 16); } }
            { const bool hi = (lane & 8) != 0;
#pragma unroll
              for (int k = 0; k < 4; ++k) { const float mine = hi ? q8[4 + k] : q8[k], send = hi ? q8[k] : q8[4 + k]; q4[k] = mine + __shfl_xor(send, 8); } }
            { const bool hi = (lane & 4) != 0;
#pragma unroll
              for (int k = 0; k < 2; ++k) { const float mine = hi ? q4[2 + k] : q4[k], send = hi ? q4[k] : q4[2 + k]; q2[k] = mine + __shfl_xor(send, 4); } }
            { const bool hi = (lane & 2) != 0; const float mine = hi ? q2[1] : q2[0], send = hi ? q2[0] : q2[1]; lg = mine + __shfl_xor(send, 2); }
            lg += __shfl_xor(lg, 1); lg += rbias;
            int si[4]; float sv[4];
#pragma unroll
            for (int k = 0; k < 4; ++k) { const float mx = wave_max(lg); const unsigned long long bal = __ballot(lg == mx); const int first = __ffsll((long long)bal) - 1; si[k] = first >> 1; sv[k] = mx; if ((lane >> 1) == si[k]) lg = -3.0e38f; }
            const float e1 = ex2((sv[1] - sv[0]) * LOG2E), e2 = ex2((sv[2] - sv[0]) * LOG2E), e3 = ex2((sv[3] - sv[0]) * LOG2E), inv = 1.0f / (1.0f + e1 + e2 + e3);
            if (lane == 0) { *(GAS v4i*)(TOPI + (size_t)t * 4) = (v4i){si[0], si[1], si[2], si[3]}; *(GAS f32x4*)(TOPW + (size_t)t * 4) = (f32x4){inv, e1 * inv, e2 * inv, e3 * inv};
#pragma unroll
                for (int k = 0; k < 4; ++k) __hip_atomic_fetch_add((LAS unsigned*)(MISC + MW_HIST + si[k]), 1u, __ATOMIC_RELAXED, __HIP_MEMORY_SCOPE_WORKGROUP); }
        }
        __syncthreads();
        if (tid < 32) { const unsigned c = MISC[MW_HIST + tid]; WGB[chunk * 32 + tid] = __hip_atomic_fetch_add(etot + tid, c, RLX_AGENT); }
        __syncthreads();
    }
}
__device__ __forceinline__ int build_tiles(const Args& a, volatile LAS unsigned* MISC, int l, int tid) {
    unsigned* etot = (unsigned*)(a.ws + WS_CTL) + CW_ETOT + 64 * l;
    __syncthreads();
    if (tid == 0) { unsigned acc = 0; for (int e = 0; e < NE; ++e) { MISC[MW_EBASE + e] = acc; const unsigned c = __hip_atomic_load(etot + e, RLX_AGENT); acc += ((c + 255u) >> 8) << 8; } MISC[MW_EBASE + NE] = acc; }
    __syncthreads();
    const int ntiles = (int)(MISC[MW_EBASE + NE] >> 8);
    volatile LAS unsigned short* te = (volatile LAS unsigned short*)(MISC + MW_TILEE);
    for (int pm = tid; pm < ntiles; pm += 512) { int e = 0; for (int k = 1; k < NE; ++k) if (MISC[MW_EBASE + k] <= (unsigned)pm * 256u) e = k; te[pm] = (unsigned short)e; }
    __syncthreads();
    return ntiles;
}
__device__ __forceinline__ void p_dispatch(const Args& a, LAS unsigned char* lds, volatile LAS unsigned* MISC, int l, int wg, int G, int wave, int lane, int tid) {
    build_tiles(a, MISC, l, tid);
    const int* TOPI = (const int*)(a.ws + WS_TOPI); int* SLOT = (int*)(a.ws + WS_SLOT); const unsigned* WGB = (const unsigned*)(a.ws + WS_WGB);
    const bf16* U = (const bf16*)(a.ws + WS_U); bf16* XG = (bf16*)(a.ws + WS_XG);
    LAS int* slotl = (LAS int*)lds;
    for (int chunk = wg; chunk < T / 256; chunk += G) {
        if (tid < 32) { MISC[MW_HIST + tid] = 0u; MISC[MW_WGB + tid] = WGB[chunk * 32 + tid]; }
        __syncthreads();
#pragma unroll
        for (int it = 0; it < 2; ++it) { const int p = tid + 512 * it; const int e = TOPI[(size_t)256 * chunk * 4 + p];
            const unsigned r = __hip_atomic_fetch_add((LAS unsigned*)(MISC + MW_HIST + e), 1u, __ATOMIC_RELAXED, __HIP_MEMORY_SCOPE_WORKGROUP);
            const int slot = (int)(MISC[MW_EBASE + e] + MISC[MW_WGB + e] + r); SLOT[(size_t)256 * chunk * 4 + p] = slot; slotl[p] = slot; }
        __syncthreads();
        for (int p = wave; p < 1024; p += 8) { const int t = 256 * chunk + (p >> 2); const int slot = slotl[p];
            const GAS v4u* src = (const GAS v4u*)(U + (size_t)t * D); GAS v4u* dst = (GAS v4u*)(XG + (size_t)slot * D);
            const v4u c0 = src[lane], c1 = src[lane + 64]; dst[lane] = c0; dst[lane + 64] = c1; }
        __syncthreads();
    }
}
__device__ __forceinline__ void p_r3(const Args& a, int l, int gw, int NGW, int lane) {
    const float* mods = (const float*)(a.ws + WS_MODS); const float* X1 = (const float*)(a.ws + WS_X1); const bf16* Z = (const bf16*)(a.ws + WS_XG);
    const int* SLOT = (const int*)(a.ws + WS_SLOT); const float* TOPW = (const float*)(a.ws + WS_TOPW);
    float* xo = l == DEPTH - 1 ? a.out : (float*)(a.ws + WS_X); bf16* U = (bf16*)(a.ws + WS_U);
    const float* l2g = a.in[I_LN2G] + l * D; const float* l2b = a.in[I_LN2B] + l * D;
    for (int t = gw; t < T; t += NGW) {
        const int b = t / SEQ; const float* mb = mods + ((size_t)l * BATCH + b) * 6 * D;
        const v4i sl = *(const GAS v4i*)(SLOT + (size_t)t * 4); const f32x4 wt = *(const GAS f32x4*)(TOPW + (size_t)t * 4);
        const int sls[4] = {sl[0], sl[1], sl[2], sl[3]};
        f32x4 f[4], x[4];
#pragma unroll
        for (int j = 0; j < 4; ++j) f[j] = (f32x4){0.f, 0.f, 0.f, 0.f};
#pragma unroll
        for (int k = 0; k < 4; ++k) { const bf16* zr = Z + (size_t)sls[k] * D;
#pragma unroll
            for (int j = 0; j < 4; ++j) { const v2u w = *(const GAS v2u*)(zr + 4 * lane + 256 * j); f[j] += wt[k] * (f32x4){bf_lo(w.x), bf_hi(w.x), bf_lo(w.y), bf_hi(w.y)}; } }
        load_row4(X1 + (size_t)t * D, lane, x);
#pragma unroll
        for (int j = 0; j < 4; ++j) { const f32x4 g2 = *(const GAS f32x4*)(mb + 5 * D + 4 * lane + 256 * j); x[j] = ALPHA * x[j] + (1.0f + g2) * f[j]; }
        float mean, rstd; ln_stats(x, mean, rstd);
#pragma unroll
        for (int j = 0; j < 4; ++j) { const f32x4 g = *(const GAS f32x4*)(l2g + 4 * lane + 256 * j), bb = *(const GAS f32x4*)(l2b + 4 * lane + 256 * j); x[j] = (x[j] - mean) * rstd * g + bb;
            *(GAS f32x4*)(xo + (size_t)t * D + 4 * lane + 256 * j) = x[j]; }
        if (l + 1 < DEPTH) { const float* mn = mods + ((size_t)(l + 1) * BATCH + b) * 6 * D; f32x4 u[4]; mod_ln_row(x, mn, mn + D, lane, u); store_row_bf16(U + (size_t)t * D, lane, u); }
    }
}

__global__ void __launch_bounds__(512, 2) fwd(Args a) {
    extern __shared__ __attribute__((aligned(16))) unsigned char lds_raw[];
    LAS unsigned char* lds = (LAS unsigned char*)lds_raw;
    volatile LAS unsigned* MISC = (volatile LAS unsigned*)(lds + MISC_OFF);
    const int tid = threadIdx.x, lane = tid & 63, wave = __builtin_amdgcn_readfirstlane(tid >> 6), G = gridDim.x, wg = blockIdx.x;
    const int gw = wg * 8 + wave, NGW = G * 8;
    unsigned* ctl = (unsigned*)(a.ws + WS_CTL);
    for (int u = tid; u < (LDS_BYTES - MISC_OFF) / 4; u += 512) MISC[u] = 0u;
    __syncthreads();
#if MK_ONE_LAUNCH
    XcdBarrier bar = xcd_barrier_post(ctl + CW_BAR, MISC);
#define GRID_BAR() xcd_barrier(bar)
#else
#define GRID_BAR() do { } while (0)
#endif
    const int lo = a.ph_lo, hi = a.ph_hi;
#define IN(k) (lo <= (k) && (k) < hi)
#define BOTH(k) (IN(k) && IN((k) + 1))
#ifndef ONLY_PHASE
#define ONLY_PHASE -1
#endif
#define PH_ON(k) (ONLY_PHASE < 0 || ONLY_PHASE == (k))
    if (PH_ON(100) && IN(0)) { p0_mods(a, lds, wg, G, wave, lane, tid); p0_convert(a, lds, gw, NGW, wave, lane); if (BOTH(0)) GRID_BAR(); }
    if (PH_ON(101) && IN(1)) { p_r0(a, gw, NGW, lane); if (BOTH(1)) GRID_BAR(); }
#pragma unroll 1
    for (int l = 0; l < DEPTH; ++l) {
        const int g0 = 2 + NPH_LAYER * l;
#define OPAQUE_TID() int tid = threadIdx.x; asm volatile("" : "+v"(tid)); const int lane = tid & 63; const int wave = __builtin_amdgcn_readfirstlane(tid >> 6); const int gw = wg * 8 + wave; (void)lane; (void)gw
        if (PH_ON(0) && IN(g0 + 0)) { OPAQUE_TID();
            pg8::Gemm g{(const bf16*)(a.ws + WS_U), (const bf16*)(a.ws + WS_WIN) + (size_t)l * NIN * D, D, 0};
            pg8::TileOrder S; S.init(T / 256, NIN / 256, G, wg, nullptr);
            pg8::EpiBf16 E{(bf16*)(a.ws + WS_QKV), NIN, nullptr, 0};
            pg8::gemm_phase<pg8::EpiBf16, pg8::TileOrder, true, true>(lds, g, S, E, tid);
            if (BOTH(g0 + 0)) GRID_BAR();
        }
        if (PH_ON(1) && IN(g0 + 1)) { OPAQUE_TID();
            unsigned* qctr = ctl + CW_QCTR + 64 * l;
            constexpr int NTK = 128 + BATCH * NH * 6;
            for (;;) {
                if (tid == 0) MISC[MW_TICKET] = __hip_atomic_fetch_add(qctr, 1u, RLX_AGENT);
                __syncthreads();
                const int tk = (int)MISC[MW_TICKET];
                __syncthreads();
                if (tk >= NTK) break;
                if (tk < 128) lru::unit(lds, a, l, tk, wave, lane, tid); else att::ticket(lds, a, tk - 128, wave, lane);
            }
            if (BOTH(g0 + 1)) GRID_BAR();
        }
        if (PH_ON(2) && IN(g0 + 2)) { OPAQUE_TID(); p_merge(a, l, gw, NGW, lane); if (BOTH(g0 + 2)) GRID_BAR(); }
        if (PH_ON(3) && IN(g0 + 3)) { OPAQUE_TID();
            pg8::Gemm g{(const bf16*)(a.ws + WS_U), (const bf16*)(a.ws + WS_WOUT) + (size_t)l * D * D, D, 0};
            pg8::TileOrder S; S.init(T / 256, D / 256, G, wg, nullptr);
            pg8::EpiBf16 E{(bf16*)(a.ws + WS_MIX), D, nullptr, 0};
            pg8::gemm_phase<pg8::EpiBf16, pg8::TileOrder, true, true>(lds, g, S, E, tid);
            if (BOTH(g0 + 3)) GRID_BAR();
        }
        if (PH_ON(4) && IN(g0 + 4)) { OPAQUE_TID(); p_r2(a, lds, MISC, l, wg, G, wave, lane, tid); if (BOTH(g0 + 4)) GRID_BAR(); }
        if (PH_ON(5) && IN(g0 + 5)) { OPAQUE_TID(); p_dispatch(a, lds, MISC, l, wg, G, wave, lane, tid); if (BOTH(g0 + 5)) GRID_BAR(); }
        if (PH_ON(6) && IN(g0 + 6)) { OPAQUE_TID();
            const int ntiles = build_tiles(a, MISC, l, tid);
            pg8::Gemm g{(const bf16*)(a.ws + WS_XG), (const bf16*)(a.ws + WS_W1) + (size_t)l * NE * 2 * DFF * D, D, (size_t)2 * DFF * D * 2};
            pg8::TileOrder S; S.init(ntiles, 8, G, wg, (const LAS unsigned short*)(MISC + MW_TILEE));
            pg8::EpiSwiglu E{(bf16*)(a.ws + WS_ACT), a.in[I_B1] + (size_t)l * NE * 2 * DFF};
            pg8::gemm_phase<pg8::EpiSwiglu, pg8::TileOrder, true, true>(lds, g, S, E, tid);
            if (BOTH(g0 + 6)) GRID_BAR();
        }
        if (PH_ON(7) && IN(g0 + 7)) { OPAQUE_TID();
            const int ntiles = build_tiles(a, MISC, l, tid);
            pg8::Gemm g{(const bf16*)(a.ws + WS_ACT), (const bf16*)(a.ws + WS_W2) + (size_t)l * NE * D * DFF, DFF, (size_t)D * DFF * 2};
            pg8::TileOrder S; S.init(ntiles, 4, G, wg, (const LAS unsigned short*)(MISC + MW_TILEE));
            pg8::EpiBf16 E{(bf16*)(a.ws + WS_XG), D, a.in[I_B2] + (size_t)l * NE * D, D};
            pg8::gemm_phase<pg8::EpiBf16, pg8::TileOrder, true, true>(lds, g, S, E, tid);
            if (BOTH(g0 + 7)) GRID_BAR();
        }
        if (PH_ON(8) && IN(g0 + 8)) { OPAQUE_TID(); p_r3(a, l, gw, NGW, lane); if (BOTH(g0 + 8)) GRID_BAR(); }
    }
}

extern "C" void kernel_launch(void* const* d_in, const int* in_sizes, int n_in, void* d_out, int out_size, void* d_ws, size_t ws_size, hipStream_t stream) {
    static int grid = 0;
    if (grid == 0) {
        if (n_in != 25 || out_size != T * D || ws_size < WS_END) { fprintf(stderr, "kernel_launch: unexpected shapes (n_in %d out %d ws %zu)\n", n_in, out_size, ws_size); grid = -1; return; }
        int dev = 0, cus = 0, per_cu = 0;
        if (hipGetDevice(&dev) != hipSuccess || hipDeviceGetAttribute(&cus, hipDeviceAttributeMultiprocessorCount, dev) != hipSuccess) { grid = -1; return; }
        if (hipFuncSetAttribute((const void*)fwd, hipFuncAttributeMaxDynamicSharedMemorySize, LDS_BYTES) != hipSuccess) { fprintf(stderr, "kernel_launch: hipFuncSetAttribute failed\n"); grid = -1; return; }
        if (hipOccupancyMaxActiveBlocksPerMultiprocessor(&per_cu, (const void*)fwd, 512, LDS_BYTES) != hipSuccess || per_cu < 1) fprintf(stderr, "kernel_launch: occupancy query reports %d\n", per_cu);
        (void)hipGetLastError();
        grid = cus;
    }
    if (grid < 0) return;
    (void)hipMemsetAsync((char*)d_ws + WS_CTL, 0, CTL_ZERO_BYTES, stream);
    Args a{};
    for (int i = 0; i < 25; ++i) a.in[i] = (const float*)d_in[i];
    a.out = (float*)d_out; a.ws = (unsigned char*)d_ws;
#if MK_ONE_LAUNCH
    a.ph_lo = 0; a.ph_hi = NPH;
    hipLaunchKernelGGL(fwd, dim3(grid), dim3(512), LDS_BYTES, stream, a);
#else
    for (int p = 0; p < NPH; ++p) { a.ph_lo = p; a.ph_hi = p + 1; hipLaunchKernelGGL(fwd, dim3(grid), dim3(512), LDS_BYTES, stream, a); }
#endif
}
```

```cpp
#include <hip/hip_runtime.h>
#include <cstdio>
#include <cstdint>
namespace pg8 {
#define PG8_LAS __attribute__((address_space(3)))
typedef unsigned short bf16_t;
typedef short bf16x8 __attribute__((ext_vector_type(8)));
typedef float f32x4 __attribute__((ext_vector_type(4)));
typedef float f32x2 __attribute__((ext_vector_type(2)));
typedef unsigned u32x4 __attribute__((ext_vector_type(4)));
typedef unsigned u32x2 __attribute__((ext_vector_type(2)));
typedef int v8i32 __attribute__((ext_vector_type(8)));
constexpr int BM = 256, BK = 64, HALF = 128, HTB = HALF * BK * 2, STAGE_BYTES = 8 * HTB, NXCD = 8, WGM = 8;
constexpr int BIAS_LDS_OFF = STAGE_BYTES + 1024 + 4096;
__host__ __device__ __forceinline__ int lds_byte(int r, int c) { const int st = (r >> 4) * 2 + (c >> 5), rr = r & 15, cc = c & 31, ob = rr * 64 + cc * 2; return st * 1024 + (ob ^ (((ob >> 9) & 1) << 5)); }
__host__ __device__ __forceinline__ void stage_rc(int b, int& R, int& C) { const int st = b / 1024, sb = b % 1024, swz = sb ^ (((sb >> 9) & 1) << 5); R = (st >> 1) * 16 + swz / 64; C = (st & 1) * 32 + (swz % 64) / 2; }
__host__ __device__ __forceinline__ int perm32(int rho) { const int n = rho >> 4, i = rho & 15; return 8 * (i >> 2) + 4 * n + (i & 3); }
struct Unit { int pm, pn, e, par; };
struct Gemm { const bf16_t* A; const bf16_t* Bt; int K; size_t bstride; const int* rowmap; };
struct TileOrder {
    int nM, nN, nwg, G, c, wgm; const PG8_LAS unsigned short* tile_e;
    __device__ void init(int nM_, int nN_, int G_, int c_, const PG8_LAS unsigned short* te, int wgm_ = WGM) { nM = nM_; nN = nN_; nwg = nM * nN; G = G_; c = c_; tile_e = te; wgm = wgm_; }
    __device__ bool next(int i, Unit& u) const {
        const long L = (long)i * G + c; if (L >= nwg) return false;
        int wgid = (int)L; { const int q = nwg / NXCD, r = nwg % NXCD, xcd = wgid % NXCD, off = wgid / NXCD; wgid = (xcd < r ? xcd * (q + 1) : r * (q + 1) + (xcd - r) * q) + off; }
        const int nig = wgm * nN, gid = wgid / nig, fm = gid * wgm, gsz = (nM - fm) < wgm ? (nM - fm) : wgm;
        u.pm = fm + ((wgid % nig) % gsz); u.pn = (wgid % nig) / gsz; u.e = tile_e ? (int)tile_e[u.pm] : 0; return true;
    }
    __device__ __forceinline__ void a_ready(const Unit&) const {}
    __device__ __forceinline__ void done(const Unit&) const {}
};
__device__ __forceinline__ unsigned cvt_pk_bf16(float lo, float hi) { typedef __bf16 bf2_t __attribute__((ext_vector_type(2))); const f32x2 v = {lo, hi}; return __builtin_bit_cast(unsigned, __builtin_convertvector(v, bf2_t)); }
__device__ __forceinline__ unsigned pk4_fp8(float a, float b, float c, float d) { int w = 0; w = __builtin_amdgcn_cvt_pk_fp8_f32(a, b, w, false); w = __builtin_amdgcn_cvt_pk_fp8_f32(c, d, w, true); return (unsigned)w; }
struct EpiBf16 {
    static constexpr bool PERM = true, AFTER_DRAIN = false; static constexpr int NST = 16;
    bf16_t* O; int ldc; const float* bias; int bias_stride; float scale;
    __device__ __forceinline__ void prefetch(const Unit&, int, int, PG8_LAS unsigned char*) const {}
    __device__ __forceinline__ void operator()(const f32x4 (&acc)[2][2][4][2], const Unit& u, int wr, int wc, int fr, int fq, PG8_LAS unsigned char* lds) const {
        int row0 = u.pm * BM + wr * 64 + fr; int col0 = u.pn * BM + wc * 32 + 8 * fq;
        asm volatile("" : "+v"(row0), "+v"(col0));
        f32x4 bv[2][2];
#pragma unroll
        for (int bj = 0; bj < 2; ++bj)
#pragma unroll
            for (int n = 0; n < 2; ++n) bv[bj][n] = bias ? *(const f32x4*)(bias + (size_t)u.e * bias_stride + col0 + bj * HALF + 4 * n) : (f32x4){0.f, 0.f, 0.f, 0.f};
#pragma unroll
        for (int ai = 0; ai < 2; ++ai)
#pragma unroll
            for (int m = 0; m < 4; ++m) { bf16_t* rowp = O + (size_t)(row0 + ai * HALF + m * 16) * ldc + col0;
#pragma unroll
                for (int bj = 0; bj < 2; ++bj) { const f32x4 v0 = acc[ai][bj][m][0] * scale + bv[bj][0], v1 = acc[ai][bj][m][1] * scale + bv[bj][1];
                    u32x4 w; w.x = cvt_pk_bf16(v0[0], v0[1]); w.y = cvt_pk_bf16(v0[2], v0[3]); w.z = cvt_pk_bf16(v1[0], v1[1]); w.w = cvt_pk_bf16(v1[2], v1[3]);
                    *(u32x4*)(rowp + bj * HALF) = w; } }
    }
};
struct EpiFp8 {
    static constexpr bool PERM = true, AFTER_DRAIN = false; static constexpr int NST = 16;
    unsigned char* O; int ldc; const float* bias; int bias_stride; float scale, out_scale;
    __device__ __forceinline__ void prefetch(const Unit& u, int wid, int lane, PG8_LAS unsigned char* lds) const {
        if (wid == 0) __builtin_amdgcn_global_load_lds((const unsigned*)(bias + (size_t)u.e * bias_stride + u.pn * BM + 4 * lane), (PG8_LAS unsigned*)(lds + BIAS_LDS_OFF + u.par * 1024), 16, 0, 0); }
    __device__ __forceinline__ void operator()(const f32x4 (&acc)[2][2][4][2], const Unit& u, int wr, int wc, int fr, int fq, PG8_LAS unsigned char* lds) const {
        int row0 = u.pm * BM + wr * 64 + fr; int col0 = u.pn * BM + wc * 32 + 8 * fq;
        asm volatile("" : "+v"(row0), "+v"(col0));
        f32x4 bv[2][2];
#pragma unroll
        for (int bj = 0; bj < 2; ++bj)
#pragma unroll
            for (int n = 0; n < 2; ++n) bv[bj][n] = *(const PG8_LAS f32x4*)(lds + BIAS_LDS_OFF + u.par * 1024 + (wc * 32 + 8 * fq + bj * HALF + 4 * n) * 4) * out_scale;
        const float sc = scale * out_scale;
#pragma unroll
        for (int ai = 0; ai < 2; ++ai)
#pragma unroll
            for (int m = 0; m < 4; ++m) { unsigned char* rowp = O + (size_t)(row0 + ai * HALF + m * 16) * ldc + col0;
#pragma unroll
                for (int bj = 0; bj < 2; ++bj) { const f32x4 v0 = acc[ai][bj][m][0] * sc + bv[bj][0], v1 = acc[ai][bj][m][1] * sc + bv[bj][1];
                    u32x2 w; w.x = pk4_fp8(v0[0], v0[1], v0[2], v0[3]); w.y = pk4_fp8(v1[0], v1[1], v1[2], v1[3]);
                    *(u32x2*)(rowp + bj * HALF) = w; } }
    }
};
__device__ __forceinline__ float swiglu1(float g, float u) {
    g = fminf(g, 7.0f); u = fminf(fmaxf(u, -7.0f), 7.0f);
    const float sg = __builtin_amdgcn_rcpf(1.0f + __builtin_amdgcn_exp2f(g * (-1.702f * 1.44269504f)));
    return g * sg * (u + 1.0f);
}
struct EpiSwiglu8 {
    static constexpr bool PERM = true, AFTER_DRAIN = false; static constexpr int NST = 8;
    unsigned char* O; const float* b1; float in_scale, out_scale;
    __device__ __forceinline__ void prefetch(const Unit& u, int wid, int lane, PG8_LAS unsigned char* lds) const {
        if (wid == 0) __builtin_amdgcn_global_load_lds((const unsigned*)(b1 + (size_t)u.e * 2048 + (lane < 32 ? u.pn * HALF + 4 * lane : 1024 + u.pn * HALF + 4 * (lane - 32))), (PG8_LAS unsigned*)(lds + BIAS_LDS_OFF + u.par * 1024), 16, 0, 0); }
    __device__ __forceinline__ void operator()(const f32x4 (&acc)[2][2][4][2], const Unit& u, int wr, int wc, int fr, int fq, PG8_LAS unsigned char* lds) const {
        int row0 = u.pm * BM + wr * 64 + fr; int col0 = u.pn * HALF + wc * 32 + 8 * fq;
        asm volatile("" : "+v"(row0), "+v"(col0));
        f32x4 bgv[2], buv[2];
#pragma unroll
        for (int n = 0; n < 2; ++n) { bgv[n] = *(const PG8_LAS f32x4*)(lds + BIAS_LDS_OFF + u.par * 1024 + (wc * 32 + 8 * fq + 4 * n) * 4); buv[n] = *(const PG8_LAS f32x4*)(lds + BIAS_LDS_OFF + u.par * 1024 + (HALF + wc * 32 + 8 * fq + 4 * n) * 4); }
#pragma unroll
        for (int ai = 0; ai < 2; ++ai)
#pragma unroll
            for (int m = 0; m < 4; ++m) { unsigned char* rowp = O + (size_t)(row0 + ai * HALF + m * 16) * 1024 + col0;
                const f32x4 g0 = acc[ai][0][m][0] * in_scale + bgv[0], g1 = acc[ai][0][m][1] * in_scale + bgv[1], u0 = acc[ai][1][m][0] * in_scale + buv[0], u1 = acc[ai][1][m][1] * in_scale + buv[1];
                u32x2 w; w.x = pk4_fp8(swiglu1(g0[0], u0[0]) * out_scale, swiglu1(g0[1], u0[1]) * out_scale, swiglu1(g0[2], u0[2]) * out_scale, swiglu1(g0[3], u0[3]) * out_scale);
                w.y = pk4_fp8(swiglu1(g1[0], u1[0]) * out_scale, swiglu1(g1[1], u1[1]) * out_scale, swiglu1(g1[2], u1[2]) * out_scale, swiglu1(g1[3], u1[3]) * out_scale);
                *(u32x2*)rowp = w; }
    }
};
struct EpiSwiglu {
    static constexpr bool PERM = true, AFTER_DRAIN = false; static constexpr int NST = 8;
    bf16_t* O; const float* b1;
    __device__ __forceinline__ void prefetch(const Unit&, int, int, PG8_LAS unsigned char*) const {}
    __device__ __forceinline__ void operator()(const f32x4 (&acc)[2][2][4][2], const Unit& u, int wr, int wc, int fr, int fq, PG8_LAS unsigned char* lds) const {
        int row0 = u.pm * BM + wr * 64 + fr; int col0 = u.pn * HALF + wc * 32 + 8 * fq;
        asm volatile("" : "+v"(row0), "+v"(col0));
        const float* bg = b1 + (size_t)u.e * 2048 + col0;
        f32x4 bgv[2], buv[2];
#pragma unroll
        for (int n = 0; n < 2; ++n) { bgv[n] = *(const f32x4*)(bg + 4 * n); buv[n] = *(const f32x4*)(bg + 1024 + 4 * n); }
#pragma unroll
        for (int ai = 0; ai < 2; ++ai)
#pragma unroll
            for (int m = 0; m < 4; ++m) { bf16_t* rowp = O + (size_t)(row0 + ai * HALF + m * 16) * 1024 + col0;
                const f32x4 g0 = acc[ai][0][m][0] + bgv[0], g1 = acc[ai][0][m][1] + bgv[1], u0 = acc[ai][1][m][0] + buv[0], u1 = acc[ai][1][m][1] + buv[1];
                u32x4 w; w.x = cvt_pk_bf16(swiglu1(g0[0], u0[0]), swiglu1(g0[1], u0[1])); w.y = cvt_pk_bf16(swiglu1(g0[2], u0[2]), swiglu1(g0[3], u0[3]));
                w.z = cvt_pk_bf16(swiglu1(g1[0], u1[0]), swiglu1(g1[1], u1[1])); w.w = cvt_pk_bf16(swiglu1(g1[2], u1[2]), swiglu1(g1[3], u1[3]));
                *(u32x4*)rowp = w; }
    }
};
template <class Epi, class Sched, bool ALIGN_EPI = false, bool SP2 = false, bool F8 = false, bool GATHER = false>
__device__ __forceinline__ void gemm_phase(PG8_LAS unsigned char* lds, const Gemm g, const Sched& S, const Epi& E, const int tid_in) {
    const int tid = tid_in, wid = __builtin_amdgcn_readfirstlane(tid >> 6), lane = tid & 63, wr = wid >> 2, wc = wid & 3, fr = lane & 15, fq = lane >> 4;
    const int K = g.K, nt = K / BK;
    unsigned voffA[2], voffB[2];
#pragma unroll
    for (int i = 0; i < 2; ++i) { int R, C; stage_rc(tid * 16 + i * 8192, R, C); const int Rb = Epi::PERM ? ((R & ~31) + perm32(R & 31)) : R;
        voffA[i] = (unsigned)(R * K + C) * 2u; voffB[i] = (unsigned)(Rb * K + C) * 2u; }
    unsigned ga_cur[2][2], ga_nxt[2][2];
#define PG8_LOADGA(dst, unit) do { _Pragma("unroll") for (int _i = 0; _i < 2; ++_i) { int _R, _C; stage_rc(tid * 16 + _i * 8192, _R, _C); _Pragma("unroll") for (int _h = 0; _h < 2; ++_h) \
        dst[_h][_i] = (unsigned)g.rowmap[(unit).pm * BM + _R + HALF * _h] * (unsigned)(K * 2) + (unsigned)_C * 2u; } } while (0)
    const size_t kstep = (size_t)(BK * 2);
    const size_t hstep = (size_t)HALF * K * 2;
    const size_t tstep = 2 * hstep;
    const unsigned ldsw = (unsigned)wid * 1024u;
    const int aoff = lds_byte(wr * 64 + fr, fq * 8), boff = lds_byte(wc * 32 + fr, fq * 8);
#define PG8_SA(b, h) (((b) * 2 + (h)) * HTB)
#define PG8_SB(b, h) ((4 + (b) * 2 + (h)) * HTB)
#define PG8_STAGE(bufoff, gbase, voff) do { _Pragma("unroll") for (int _i = 0; _i < 2; ++_i) \
        __builtin_amdgcn_global_load_lds((const unsigned*)((const char*)(gbase) + (voff)[_i]), (PG8_LAS unsigned*)(lds + (bufoff) + ldsw + _i * 8192), 16, 0, 0); } while (0)
#define PG8_LDA(dst, b, h) do { _Pragma("unroll") for (int m = 0; m < 4; ++m) _Pragma("unroll") for (int k = 0; k < 2; ++k) dst[m][k] = *(const PG8_LAS bf16x8*)(lds + PG8_SA(b, h) + aoff + m * 2048 + k * 1024); } while (0)
#define PG8_LDB(dst, b, h) do { _Pragma("unroll") for (int n = 0; n < 2; ++n) _Pragma("unroll") for (int k = 0; k < 2; ++k) dst[n][k] = *(const PG8_LAS bf16x8*)(lds + PG8_SB(b, h) + boff + n * 2048 + k * 1024); } while (0)
#define PG8_CAT8(x, y) __builtin_bit_cast(v8i32, __builtin_shufflevector((x), (y), 0, 1, 2, 3, 4, 5, 6, 7, 8, 9, 10, 11, 12, 13, 14, 15))
#define PG8_MMA(ai, bj, At, Bt) do { __builtin_amdgcn_s_setprio(1); \
        if constexpr (F8) { _Pragma("unroll") for (int m = 0; m < 4; ++m) _Pragma("unroll") for (int n = 0; n < 2; ++n) \
            asm volatile("v_mfma_scale_f32_16x16x128_f8f6f4 %0, %1, %2, %0, %3, %3 op_sel_hi:[0,0,0]" : "+v"(acc[ai][bj][m][n]) : "v"(PG8_CAT8(Bt[n][0], Bt[n][1])), "v"(PG8_CAT8(At[m][0], At[m][1])), "v"(f8_scale)); } \
        else { _Pragma("unroll") for (int m = 0; m < 4; ++m) _Pragma("unroll") for (int n = 0; n < 2; ++n) _Pragma("unroll") for (int k = 0; k < 2; ++k) \
            acc[ai][bj][m][n] = __builtin_amdgcn_mfma_f32_16x16x32_bf16(Bt[n][k], At[m][k], acc[ai][bj][m][n], 0, 0, 0); } \
        __builtin_amdgcn_s_setprio(0); } while (0)
#define PG8_WAIT_V(n) asm volatile("s_waitcnt vmcnt(" #n ")" ::: "memory")
#define PG8_WAIT_VR(relax) do { if (relax) asm volatile("s_waitcnt vmcnt(%0)" :: "n"(8 + Epi::NST) : "memory"); else asm volatile("s_waitcnt vmcnt(8)" ::: "memory"); } while (0)
#define PG8_WAIT_L(n) asm volatile("s_waitcnt lgkmcnt(" #n ")" ::: "memory")
#define PG8_BAR __builtin_amdgcn_s_barrier()
#define PG8_SCHED __builtin_amdgcn_sched_barrier(0)
    const int f8_scale = 0x7f7f7f7f; (void)f8_scale;
    Unit cur, nxt; int ui = 0;
    if (!S.next(0, cur)) return;
    f32x4 acc[2][2][4][2];
#pragma unroll
    for (int a = 0; a < 2; ++a)
#pragma unroll
        for (int b = 0; b < 2; ++b)
#pragma unroll
            for (int m = 0; m < 4; ++m)
#pragma unroll
                for (int n = 0; n < 2; ++n) acc[a][b][m][n] = (f32x4){0.f, 0.f, 0.f, 0.f};
    bf16x8 At[4][2], B0[2][2], B1[2][2];
    const char* cA = (const char*)g.A + (GATHER ? (size_t)0 : (size_t)cur.pm * tstep); const char* cB = (const char*)g.Bt + (size_t)cur.e * g.bstride + (size_t)cur.pn * tstep;
    const size_t hstepA = GATHER ? (size_t)0 : hstep;
    unsigned vA0c[2], vA1c[2];
    if constexpr (GATHER) { PG8_LOADGA(ga_cur, cur); vA0c[0] = ga_cur[0][0]; vA0c[1] = ga_cur[0][1]; vA1c[0] = ga_cur[1][0]; vA1c[1] = ga_cur[1][1]; }
    else { vA0c[0] = vA1c[0] = voffA[0]; vA0c[1] = vA1c[1] = voffA[1]; }
    cur.par = 0; E.prefetch(cur, wid, lane, lds);
    S.a_ready(cur);
    if constexpr (SP2) {
        PG8_STAGE(PG8_SB(0, 0), cB, voffB); PG8_STAGE(PG8_SB(0, 1), cB + hstep, voffB); PG8_STAGE(PG8_SA(0, 0), cA, vA0c); PG8_STAGE(PG8_SA(0, 1), cA + hstepA, vA1c);
        if (wr == 1) PG8_BAR;
        PG8_WAIT_V(2); PG8_BAR;
        PG8_STAGE(PG8_SB(1, 0), cB + kstep, voffB); PG8_STAGE(PG8_SA(1, 0), cA + kstep, vA0c); PG8_STAGE(PG8_SB(1, 1), cB + hstep + kstep, voffB);
        PG8_WAIT_V(6); PG8_BAR;
    } else {
        PG8_STAGE(PG8_SB(0, 0), cB, voffB); PG8_STAGE(PG8_SA(0, 0), cA, voffA); PG8_STAGE(PG8_SB(0, 1), cB + hstep, voffB); PG8_STAGE(PG8_SA(0, 1), cA + hstep, voffA);
        if (wr == 1) PG8_BAR;
        PG8_WAIT_V(4); PG8_BAR;
        PG8_STAGE(PG8_SB(1, 0), cB + kstep, voffB); PG8_STAGE(PG8_SA(1, 0), cA + kstep, voffA); PG8_STAGE(PG8_SB(1, 1), cB + hstep + kstep, voffB);
        PG8_WAIT_V(6); PG8_BAR;
    }
    for (;;) {
        const bool has_next = S.next(ui + 1, nxt); nxt.par = (ui + 1) & 1;
        const char* nA = (has_next && !GATHER) ? (const char*)g.A + (size_t)nxt.pm * tstep : cA;
        if constexpr (GATHER) { _Pragma("unroll") for (int _h = 0; _h < 2; ++_h) _Pragma("unroll") for (int _i = 0; _i < 2; ++_i) ga_nxt[_h][_i] = ga_cur[_h][_i]; } const char* nB = has_next ? (const char*)g.Bt + (size_t)nxt.e * g.bstride + (size_t)nxt.pn * tstep : cB;
#pragma unroll 1
        for (int t = 0; t < nt; t += 2) {
            const bool last = (t == nt - 2);
            unsigned vA0s[2], vA1s[2];
            if constexpr (GATHER) {
                if (has_next && t == nt - 4) PG8_LOADGA(ga_nxt, nxt);
                if (last) { vA0s[0] = ga_nxt[0][0]; vA0s[1] = ga_nxt[0][1]; vA1s[0] = ga_nxt[1][0]; vA1s[1] = ga_nxt[1][1]; }
                else { vA0s[0] = ga_cur[0][0]; vA0s[1] = ga_cur[0][1]; vA1s[0] = ga_cur[1][0]; vA1s[1] = ga_cur[1][1]; }
                vA1c[0] = ga_cur[1][0]; vA1c[1] = ga_cur[1][1];
            } else { vA0s[0] = vA1s[0] = voffA[0]; vA0s[1] = vA1s[1] = voffA[1]; }
            const char* a1 = cA + (size_t)(t + 1) * kstep;
            const char* a2 = last ? nA : cA + (size_t)(t + 2) * kstep; const char* b2 = last ? nB : cB + (size_t)(t + 2) * kstep;
            const char* a3 = a2 + kstep; const char* b3 = b2 + kstep;
            if (last && has_next) S.a_ready(nxt);
            const bool relax = SP2 && ALIGN_EPI && t == 0 && ui > 0;
            if constexpr (SP2) {
            PG8_LDB(B0, 0, 0); PG8_LDB(B1, 0, 1); PG8_SCHED; PG8_LDA(At, 0, 0); if (!relax) PG8_STAGE(PG8_SA(1, 1), a1 + hstepA, vA1c);
            PG8_WAIT_VR(relax); PG8_WAIT_L(0); PG8_BAR; PG8_MMA(0, 0, At, B0); PG8_MMA(0, 1, At, B1); PG8_BAR; PG8_SCHED;
            PG8_LDA(At, 0, 1); PG8_STAGE(PG8_SB(0, 0), b2, voffB); PG8_STAGE(PG8_SB(0, 1), b2 + hstep, voffB); PG8_STAGE(PG8_SA(0, 0), a2, vA0s);
            PG8_WAIT_VR(relax); PG8_WAIT_L(0); PG8_BAR; PG8_MMA(1, 0, At, B0); PG8_MMA(1, 1, At, B1); PG8_BAR; PG8_SCHED;
            PG8_LDB(B0, 1, 0); PG8_LDB(B1, 1, 1); PG8_SCHED; PG8_LDA(At, 1, 0); PG8_STAGE(PG8_SA(0, 1), a2 + hstepA, vA1s);
            PG8_WAIT_VR(relax); PG8_WAIT_L(0); PG8_BAR; PG8_MMA(0, 0, At, B0); PG8_MMA(0, 1, At, B1); PG8_BAR; PG8_SCHED;
            PG8_LDA(At, 1, 1); PG8_STAGE(PG8_SB(1, 0), b3, voffB); PG8_STAGE(PG8_SB(1, 1), b3 + hstep, voffB); PG8_STAGE(PG8_SA(1, 0), a3, vA0s);
            PG8_WAIT_V(8); PG8_WAIT_L(0); PG8_BAR; PG8_MMA(1, 0, At, B0); PG8_MMA(1, 1, At, B1); PG8_BAR; PG8_SCHED;
            } else {
            PG8_LDB(B0, 0, 0); PG8_SCHED; PG8_LDA(At, 0, 0); PG8_STAGE(PG8_SA(1, 1), a1 + hstep, voffA);
            PG8_WAIT_L(8); PG8_BAR; PG8_WAIT_L(0); PG8_MMA(0, 0, At, B0); PG8_BAR; PG8_SCHED;
            PG8_LDB(B1, 0, 1); PG8_STAGE(PG8_SB(0, 0), b2, voffB);
            PG8_BAR; PG8_WAIT_L(0); PG8_MMA(0, 1, At, B1); PG8_BAR;
            PG8_LDA(At, 0, 1); PG8_STAGE(PG8_SA(0, 0), a2, voffA);
            PG8_BAR; PG8_WAIT_L(0); PG8_MMA(1, 0, At, B0); PG8_BAR; PG8_SCHED;
            PG8_STAGE(PG8_SB(0, 1), b2 + hstep, voffB);
            PG8_WAIT_V(6); PG8_BAR; PG8_MMA(1, 1, At, B1); PG8_BAR;
            PG8_LDB(B0, 1, 0); PG8_SCHED; PG8_LDA(At, 1, 0); PG8_STAGE(PG8_SA(0, 1), a2 + hstep, voffA);
            PG8_WAIT_L(8); PG8_BAR; PG8_WAIT_L(0); PG8_MMA(0, 0, At, B0); PG8_BAR; PG8_SCHED;
            PG8_LDB(B1, 1, 1); PG8_STAGE(PG8_SB(1, 0), b3, voffB);
            PG8_BAR; PG8_WAIT_L(0); PG8_MMA(0, 1, At, B1); PG8_BAR;
            PG8_LDA(At, 1, 1); PG8_STAGE(PG8_SA(1, 0), a3, voffA);
            PG8_BAR; PG8_WAIT_L(0); PG8_MMA(1, 0, At, B0); PG8_BAR; PG8_SCHED;
            PG8_STAGE(PG8_SB(1, 1), b3 + hstep, voffB);
            PG8_WAIT_V(6); PG8_BAR; PG8_MMA(1, 1, At, B1); PG8_BAR;
            }
        }
        if constexpr (F8) asm volatile("s_nop 15\n\ts_nop 7" ::: "memory");
        if constexpr (ALIGN_EPI) { if (wr == 0) PG8_BAR; }
        if constexpr (SP2 && ALIGN_EPI) { if (has_next) {
            if constexpr (GATHER) { unsigned vn[2] = {ga_nxt[1][0], ga_nxt[1][1]}; PG8_STAGE(PG8_SA(1, 1), nA + kstep, vn); } else PG8_STAGE(PG8_SA(1, 1), nA + kstep + hstep, voffA); } }
        if constexpr (!Epi::AFTER_DRAIN) { E(acc, cur, wr, wc, fr, fq, lds); S.done(cur); }
        if (!has_next) break;
#pragma unroll
        for (int a = 0; a < 2; ++a)
#pragma unroll
            for (int b = 0; b < 2; ++b)
#pragma unroll
                for (int m = 0; m < 4; ++m)
#pragma unroll
                    for (int n = 0; n < 2; ++n) acc[a][b][m][n] = (f32x4){0.f, 0.f, 0.f, 0.f};
        cur = nxt; cA = nA; cB = nB; ++ui; E.prefetch(cur, wid, lane, lds);
        if constexpr (GATHER) { _Pragma("unroll") for (int _h = 0; _h < 2; ++_h) _Pragma("unroll") for (int _i = 0; _i < 2; ++_i) ga_cur[_h][_i] = ga_nxt[_h][_i]; vA0c[0] = ga_cur[0][0]; vA0c[1] = ga_cur[0][1]; }
        if constexpr (ALIGN_EPI) { if (wr == 1) PG8_BAR; }
    }
    PG8_WAIT_V(0);
    if constexpr (!ALIGN_EPI) { if (wr == 0) PG8_BAR; }
    PG8_BAR;
    if constexpr (Epi::AFTER_DRAIN) { E.fused(acc, cur, wr, wc, fr, fq, lds, wid, lane); S.done(cur); }
#undef PG8_SA
#undef PG8_SB
#undef PG8_STAGE
#undef PG8_LDA
#undef PG8_LDB
#undef PG8_MMA
#undef PG8_LOADGA
#undef PG8_CAT8
#undef PG8_WAIT_V
#undef PG8_WAIT_VR
#undef PG8_WAIT_L
#undef PG8_BAR
#undef PG8_SCHED
}
}

#define GAS __attribute__((address_space(1)))
#define LAS __attribute__((address_space(3)))
typedef unsigned short bf16;
typedef unsigned v4u __attribute__((ext_vector_type(4)));
typedef unsigned v2u __attribute__((ext_vector_type(2)));
typedef float f32x4 __attribute__((ext_vector_type(4)));
typedef float f32x2 __attribute__((ext_vector_type(2)));
typedef short bf16x8 __attribute__((ext_vector_type(8)));
typedef short s16x4 __attribute__((ext_vector_type(4)));
typedef int v4i __attribute__((ext_vector_type(4)));
#define RLX_AGENT __ATOMIC_RELAXED, __HIP_MEMORY_SCOPE_AGENT
#define LDS_WAIT() asm volatile("s_waitcnt lgkmcnt(0)" ::: "memory")
#define VM_WAIT() asm volatile("s_waitcnt vmcnt(0)" ::: "memory")

#ifndef MK_ONE_LAUNCH
#define MK_ONE_LAUNCH 1
#endif

constexpr int BATCH = 32, SEQ = 2048, D = 1024, DEPTH = 4, T = BATCH * SEQ;
constexpr int NH = 12, HD = 64, AW = 768, LW = 256, NIN = 2816, NE = 32, TOPK = 4, DFF = 1024;
constexpr float ALPHA = 1.6817928305074292f, LN_EPS = 1e-5f, RMS_EPS = 1e-6f, LOG2E = 1.4426950408889634f;
constexpr int NSLOT_MAX = T * TOPK + NE * 256;
constexpr int NPH_LAYER = 9, NPH = 2 + DEPTH * NPH_LAYER;

constexpr size_t MiB = 1u << 20;
constexpr size_t WS_CTL = 0, CTL_ZERO_BYTES = 1 * MiB;
constexpr size_t WS_MODS = 1 * MiB, WS_TOPI = 4 * MiB, WS_TOPW = 5 * MiB, WS_SLOT = 6 * MiB, WS_WGB = 7 * MiB;
constexpr size_t WS_LSE = 8 * MiB, WS_WIN = 18 * MiB, WS_WOUT = 40 * MiB, WS_W1 = 48 * MiB, WS_W2 = 560 * MiB;
constexpr size_t WS_U = 816 * MiB, WS_QKV = 944 * MiB, WS_ATTP = 1296 * MiB, WS_LRU = 1584 * MiB, WS_MIX = 1616 * MiB;
constexpr size_t WS_X = 1744 * MiB, WS_X1 = 2000 * MiB, WS_XG = 2256 * MiB, WS_ACT = 2784 * MiB, WS_U8 = 3312 * MiB, WS_ROWMAP = 3376 * MiB  , WS_END = 3378 * MiB;
static_assert((size_t)NSLOT_MAX * D * 2 <= 528 * MiB, "slot buffers");
constexpr int CW_TMO = 0, CW_BAR = 4096, CW_QCTR = 8192, CW_ETOT = 16384;

constexpr int RING_BYTES = 131072, MISC_OFF = RING_BYTES + 1024, LDS_BYTES = RING_BYTES + 8192;
constexpr int MW_TICKET = 4, MW_HIST = 16, MW_WGB = 48, MW_EBASE = 80, MW_TILEE = 128, MW_ETOT = 700;

__device__ __forceinline__ unsigned f2bf(float f) { unsigned u = __builtin_bit_cast(unsigned, f); return (u + 0x7fffu + ((u >> 16) & 1u)) >> 16; }
__device__ __forceinline__ unsigned pk2(float lo, float hi) { typedef __bf16 bf2_t __attribute__((ext_vector_type(2))); const f32x2 v = {lo, hi}; return __builtin_bit_cast(unsigned, __builtin_convertvector(v, bf2_t)); }
__device__ __forceinline__ unsigned pk4_fp8(float a, float b, float c, float d) { int w = 0; w = __builtin_amdgcn_cvt_pk_fp8_f32(a, b, w, false); w = __builtin_amdgcn_cvt_pk_fp8_f32(c, d, w, true); return (unsigned)w; }
constexpr float F8_SW = 64.0f, F8_SA1 = 4.0f, F8_SA2 = 4.0f, F8_SZ = 32.0f;
typedef __bf16 bf16x2_t __attribute__((ext_vector_type(2)));
__device__ __forceinline__ unsigned pk2v(float lo, float hi) { const f32x2 v = {lo, hi}; const bf16x2_t b = __builtin_convertvector(v, bf16x2_t); return __builtin_bit_cast(unsigned, b); }
__device__ __forceinline__ float bf_lo(unsigned w) { return __builtin_bit_cast(float, w << 16); }
__device__ __forceinline__ float bf_hi(unsigned w) { return __builtin_bit_cast(float, w & 0xffff0000u); }
__device__ __forceinline__ float ex2(float x) { return __builtin_amdgcn_exp2f(x); }
__device__ __forceinline__ float rcp(float x) { return __builtin_amdgcn_rcpf(x); }
__device__ __forceinline__ float sigmoidf_(float x) { return rcp(1.0f + ex2(-LOG2E * x)); }

#define XB_TMO      128
#define XB_XCNT(j)  (256  + 64 * (j))
#define XB_XSUB(j)  (1280 + 64 * (j))
#define XB_XGEN(j)  (2304 + 64 * (j))
#define XB_TOP      3328
#define XB_TOPGEN   3392
#define XCD_BAR_WORDS 3456
#define XB_SPIN_CAP (1u << 18)

__device__ __forceinline__ unsigned xb_ld(unsigned* p)              { return __hip_atomic_load(p, __ATOMIC_RELAXED, __HIP_MEMORY_SCOPE_AGENT); }
__device__ __forceinline__ unsigned xb_add(unsigned* p, unsigned v) { return __hip_atomic_fetch_add(p, v, __ATOMIC_RELAXED, __HIP_MEMORY_SCOPE_AGENT); }
__device__ __forceinline__ unsigned xb_xcc_id() { return (unsigned)__builtin_amdgcn_s_getreg((3 << 11) | 20) & 0xFu; }
#define XB_SPIN(cond, bar) do { unsigned _sp = 0; while (cond) { __builtin_amdgcn_s_sleep(1); \
    if ((++_sp & 255u) == 0u) { if (xb_ld(&(bar)[XB_TMO])) break; if (_sp > XB_SPIN_CAP) { atomicAdd(&(bar)[XB_TMO], 1u); break; } } } } while (0)

struct XcdBarrier {
    unsigned* bar; unsigned x;
    volatile LAS unsigned* st;
};

__device__ __forceinline__ XcdBarrier xcd_barrier_post(unsigned* bar, volatile LAS unsigned* st) {
    XcdBarrier b; b.bar = bar; b.x = xb_xcc_id(); b.st = st;
    if (threadIdx.x == 0) (void)xb_add(&bar[XB_XCNT(b.x)], 1u);
    return b;
}
__device__ __forceinline__ void xcd_barrier_complete(unsigned* bar, unsigned x, unsigned& nloc, unsigned& nx) {
    const unsigned G = gridDim.x * gridDim.y * gridDim.z;
    unsigned sum, cnt, mine, sp = 0u;
    for (;;) {
        sum = 0u; cnt = 0u; mine = 0u;
#pragma unroll
        for (unsigned j = 0; j < 16; ++j) { const unsigned c = xb_ld(&bar[XB_XCNT(j)]); sum += c; cnt += (c > 0u) ? 1u : 0u; mine = (j == x) ? c : mine; }
        if (sum == G) break;
        __builtin_amdgcn_s_sleep(1);
        if ((++sp & 255u) == 0u) { if (xb_ld(&bar[XB_TMO])) break; if (sp > XB_SPIN_CAP) { atomicAdd(&bar[XB_TMO], 1u); break; } }
    }
    nloc = mine > 0u ? mine : 1u; nx = cnt > 0u ? cnt : 1u;
}

__device__ __forceinline__ void xcd_barrier(const XcdBarrier& b) {
    asm volatile("s_waitcnt vmcnt(0)" ::: "memory");
    __syncthreads();
    if (threadIdx.x == 0) {
        unsigned* bar = b.bar;
        __builtin_amdgcn_s_waitcnt(0);
        unsigned nloc = b.st[0], nx = b.st[1];
        if (nloc == 0u) { xcd_barrier_complete(bar, b.x, nloc, nx); b.st[0] = nloc; b.st[1] = nx; }
        const unsigned old = xb_add(&bar[XB_XSUB(b.x)], 1u);
        const unsigned gen = old / nloc;
        if (old + 1u == (gen + 1u) * nloc) {
            __builtin_amdgcn_fence(__ATOMIC_RELEASE, "agent");
            asm volatile("s_waitcnt vmcnt(0)" ::: "memory");
            const unsigned og = xb_add(&bar[XB_TOP], 1u);
            const unsigned tg = og / nx;
            if (og + 1u == (tg + 1u) * nx) xb_add(&bar[XB_TOPGEN], 1u);
            else XB_SPIN(xb_ld(&bar[XB_TOPGEN]) == tg, bar);
            __builtin_amdgcn_fence(__ATOMIC_ACQUIRE, "agent");
            xb_add(&bar[XB_XGEN(b.x)], 1u);
            asm volatile("s_waitcnt vmcnt(0)" ::: "memory");
        } else {
            XB_SPIN(xb_ld(&bar[XB_XGEN(b.x)]) == gen, bar);
            __builtin_amdgcn_fence(__ATOMIC_ACQUIRE, "agent");
            asm volatile("s_waitcnt vmcnt(0)" ::: "memory");
        }
    }
    __syncthreads();
}

template <int CTRL> __device__ __forceinline__ float dpp_f(float v) { return __builtin_bit_cast(float, __builtin_amdgcn_update_dpp(0, __builtin_bit_cast(int, v), CTRL, 0xF, 0xF, true)); }
__device__ __forceinline__ float rdlane(float v, int l) { return __builtin_bit_cast(float, __builtin_amdgcn_readlane(__builtin_bit_cast(int, v), l)); }
__device__ __forceinline__ float wave_sum(float v) {
    v += dpp_f<0xB1>(v); v += dpp_f<0x4E>(v); v += dpp_f<0x141>(v); v += dpp_f<0x140>(v);
    return (rdlane(v, 0) + rdlane(v, 16)) + (rdlane(v, 32) + rdlane(v, 48));
}
__device__ __forceinline__ float wave_max(float v) {
    v = fmaxf(v, dpp_f<0xB1>(v)); v = fmaxf(v, dpp_f<0x4E>(v)); v = fmaxf(v, dpp_f<0x141>(v)); v = fmaxf(v, dpp_f<0x140>(v));
    return fmaxf(fmaxf(rdlane(v, 0), rdlane(v, 16)), fmaxf(rdlane(v, 32), rdlane(v, 48)));
}

constexpr float ATT_C1 = 0.125f * 1.4426950408889634f;
struct Args { const float* in[25]; float* out; unsigned char* ws; int ph_lo, ph_hi; };
enum { I_X = 0, I_C, I_WCOND, I_BCOND, I_WIN, I_CONVW, I_CONVB, I_WA, I_BA, I_WX, I_BX, I_LAM, I_ANG, I_LNG, I_WOUT, I_LN1G, I_LN1B, I_RW, I_RB, I_W1, I_B1, I_W2, I_B2, I_LN2G, I_LN2B };

struct CvtItem { const float* src; unsigned char* dst; int N; int f8; float scale; };
__device__ __forceinline__ CvtItem cvt_decode(const Args& a, int it) {
    constexpr int KB = D / 32;
    constexpr int I_IN1 = KB * (NIN / 64), I_OUT1 = KB * (D / 64), I_W11 = KB * (2 * DFF / 64), I_W21 = KB * (D / 64);
    constexpr int N_IN = DEPTH * I_IN1, N_OUT = DEPTH * I_OUT1, N_W1 = DEPTH * NE * I_W11;
    CvtItem c; int r = it; c.scale = 1.0f;
    if (r < N_IN) { const int l = r / I_IN1, q = r % I_IN1, nb = q / KB, kb = q % KB; c.N = NIN; c.f8 = 0; c.scale = 64 * nb < AW ? ATT_C1 : 1.0f;
        c.src = a.in[I_WIN] + (size_t)l * D * NIN + (size_t)(32 * kb) * NIN + 64 * nb; c.dst = a.ws + WS_WIN + ((size_t)l * NIN * D + (size_t)(64 * nb) * D + 32 * kb) * 2; return c; }
    r -= N_IN;
    if (r < N_OUT) { const int l = r / I_OUT1, q = r % I_OUT1, nb = q / KB, kb = q % KB; c.N = D; c.f8 = 0;
        c.src = a.in[I_WOUT] + (size_t)l * D * D + (size_t)(32 * kb) * D + 64 * nb; c.dst = a.ws + WS_WOUT + ((size_t)l * D * D + (size_t)(64 * nb) * D + 32 * kb) * 2; return c; }
    r -= N_OUT;
    if (r < N_W1) { const int le = r / I_W11, q = r % I_W11, nb = q / KB, kb = q % KB, n0 = 64 * nb; c.N = 2 * DFF; c.f8 = 1;
        const int orow = n0 < DFF ? 256 * (n0 >> 7) + (n0 & 127) : 256 * ((n0 - DFF) >> 7) + 128 + ((n0 - DFF) & 127);
        c.src = a.in[I_W1] + (size_t)le * D * 2 * DFF + (size_t)(32 * kb) * 2 * DFF + n0; c.dst = a.ws + WS_W1 + (size_t)le * 2 * DFF * D + (size_t)orow * D + 32 * kb; return c; }
    r -= N_W1;
    { const int le = r / I_W21, q = r % I_W21, nb = q / KB, kb = q % KB; c.N = D; c.f8 = 1;
        c.src = a.in[I_W2] + (size_t)le * DFF * D + (size_t)(32 * kb) * D + 64 * nb; c.dst = a.ws + WS_W2 + (size_t)le * D * DFF + (size_t)(64 * nb) * DFF + 32 * kb; return c; }
}
__device__ __forceinline__ void cvt_load(const CvtItem& c, int lane, f32x4 (&v)[8]) {
#pragma unroll
    for (int i = 0; i < 8; ++i) { const int kk = 4 * i + (lane >> 4); v[i] = *(const GAS f32x4*)(c.src + (size_t)kk * c.N + 4 * (lane & 15)); }
}
__device__ __forceinline__ void cvt_store(const CvtItem& c, const f32x4 (&v)[8], LAS float* scr, int lane) {
#pragma unroll
    for (int i = 0; i < 8; ++i) { const int kk = 4 * i + (lane >> 4); LAS float* p = scr + kk * 65 + 4 * (lane & 15); p[0] = v[i][0]; p[1] = v[i][1]; p[2] = v[i][2]; p[3] = v[i][3]; }
    LDS_WAIT(); asm volatile("" ::: "memory");
    if (c.f8) {
#pragma unroll
        for (int j = 0; j < 2; ++j) { const int idx = lane + 64 * j, n = idx >> 1, cc = idx & 1; const LAS float* s = scr + (16 * cc) * 65 + n;
            v4u o; o.x = pk4_fp8(s[0 * 65] * F8_SW, s[1 * 65] * F8_SW, s[2 * 65] * F8_SW, s[3 * 65] * F8_SW); o.y = pk4_fp8(s[4 * 65] * F8_SW, s[5 * 65] * F8_SW, s[6 * 65] * F8_SW, s[7 * 65] * F8_SW);
            o.z = pk4_fp8(s[8 * 65] * F8_SW, s[9 * 65] * F8_SW, s[10 * 65] * F8_SW, s[11 * 65] * F8_SW); o.w = pk4_fp8(s[12 * 65] * F8_SW, s[13 * 65] * F8_SW, s[14 * 65] * F8_SW, s[15 * 65] * F8_SW);
            *(GAS v4u*)(c.dst + (size_t)n * D + 16 * cc) = o; }
    } else {
#pragma unroll
        for (int j = 0; j < 4; ++j) { const int idx = lane + 64 * j, n = idx >> 2, cc = idx & 3; const LAS float* s = scr + (8 * cc) * 65 + n;
            const float q = c.scale; v4u o; o.x = pk2(s[0 * 65] * q, s[1 * 65] * q); o.y = pk2(s[2 * 65] * q, s[3 * 65] * q); o.z = pk2(s[4 * 65] * q, s[5 * 65] * q); o.w = pk2(s[6 * 65] * q, s[7 * 65] * q);
            *(GAS v4u*)(c.dst + ((size_t)n * D + 8 * cc) * 2) = o; }
    }
    LDS_WAIT(); asm volatile("" ::: "memory");
}
constexpr int CVT_KB = D / 32, CVT_N_PROJ = DEPTH * CVT_KB * (NIN / 64) + DEPTH * CVT_KB * (D / 64), CVT_W1_L = NE * CVT_KB * (2 * DFF / 64), CVT_W2_L = NE * CVT_KB * (D / 64);
constexpr int CVT_N_W1 = DEPTH * CVT_W1_L, CVT_MOE_L = CVT_W1_L + CVT_W2_L, CVT_TICKET_ITEMS = 64, CVT_TICKETS_L = CVT_MOE_L / CVT_TICKET_ITEMS;
static_assert(CVT_MOE_L % CVT_TICKET_ITEMS == 0, "conversion tickets");
__device__ __forceinline__ int cvt_moe_item(int layer, int i) { return i < CVT_W1_L ? CVT_N_PROJ + layer * CVT_W1_L + i : CVT_N_PROJ + CVT_N_W1 + layer * CVT_W2_L + (i - CVT_W1_L); }
__device__ __forceinline__ int cvt_pro_item(int i) { return i < CVT_N_PROJ ? i : cvt_moe_item(0, i - CVT_N_PROJ); }
template <class Map> __device__ __forceinline__ void cvt_run(const Args& a, LAS float* scr, int count, int wk, int nw, int lane, Map map) {
    if (wk >= count) return;
    CvtItem cur = cvt_decode(a, map(wk)); f32x4 v[8]; cvt_load(cur, lane, v);
    for (int it = wk; it < count; it += nw) {
        const int nx = it + nw; CvtItem nxt = cur; f32x4 vn[8];
        if (nx < count) { nxt = cvt_decode(a, map(nx)); cvt_load(nxt, lane, vn); }
        cvt_store(cur, v, scr, lane);
        cur = nxt;
#pragma unroll
        for (int i = 0; i < 8; ++i) v[i] = vn[i];
    }
}
__device__ __forceinline__ void p0_convert(const Args& a, LAS unsigned char* lds, int gw, int NGW, int wave, int lane) {
    cvt_run(a, (LAS float*)(lds + wave * 8448), CVT_N_PROJ, gw, NGW, lane, [](int i) { return i; });
}
__device__ __forceinline__ void cvt_ticket(const Args& a, LAS unsigned char* lds, int layer, int tkc, int wave, int lane) {
    cvt_run(a, (LAS float*)(lds + wave * 8448), CVT_TICKET_ITEMS, wave, 8, lane, [=](int i) { return cvt_moe_item(layer, tkc * CVT_TICKET_ITEMS + i); });
}
__device__ __forceinline__ void p0_mods(const Args& a, LAS unsigned char* lds, int wg, int G, int wave, int lane, int tid) {
    LAS float* sc = (LAS float*)lds;
    for (int i = tid; i < BATCH * D; i += 512) { const float x = a.in[I_C][i]; sc[i] = x * sigmoidf_(x); }
    __syncthreads();
    float* mods = (float*)(a.ws + WS_MODS);
    constexpr int NCH = DEPTH * 6 * D / 64;
    for (int ch = wg; ch < NCH; ch += G) {
        const int l = ch / (6 * D / 64), col = (ch % (6 * D / 64)) * 64 + lane;
        const float* w = a.in[I_WCOND] + (size_t)l * D * 6 * D + col;
        float acc[4] = {0.f, 0.f, 0.f, 0.f};
        const LAS float* s0 = sc + (4 * wave) * D;
        for (int d0 = 0; d0 < D; d0 += 4) {
            float wv[4];
#pragma unroll
            for (int j = 0; j < 4; ++j) wv[j] = *(const GAS float*)(w + (size_t)(d0 + j) * 6 * D);
#pragma unroll
            for (int bb = 0; bb < 4; ++bb) { const f32x4 s = *(const LAS f32x4*)(s0 + bb * D + d0); acc[bb] += s[0] * wv[0] + s[1] * wv[1] + s[2] * wv[2] + s[3] * wv[3]; }
        }
        const float bc = a.in[I_BCOND][l * 6 * D + col];
#pragma unroll
        for (int bb = 0; bb < 4; ++bb) mods[((size_t)l * BATCH + 4 * wave + bb) * 6 * D + col] = acc[bb] + bc;
    }
    __syncthreads();
}

__device__ __forceinline__ void ln_stats(const f32x4 (&v)[4], float& mean, float& rstd) {
    float s = 0.f;
#pragma unroll
    for (int j = 0; j < 4; ++j) s += (v[j][0] + v[j][1]) + (v[j][2] + v[j][3]);
    mean = wave_sum(s) * (1.f / D); float q = 0.f;
#pragma unroll
    for (int j = 0; j < 4; ++j) { const f32x4 d = v[j] - mean; q += (d[0] * d[0] + d[1] * d[1]) + (d[2] * d[2] + d[3] * d[3]); }
    rstd = rsqrtf(wave_sum(q) * (1.f / D) + LN_EPS);
}
__device__ __forceinline__ void load_row4(const float* p, int lane, f32x4 (&v)[4]) {
#pragma unroll
    for (int j = 0; j < 4; ++j) v[j] = *(const GAS f32x4*)(p + 4 * lane + 256 * j);
}
__device__ __forceinline__ void load_row4_bf16(const bf16* p, int lane, f32x4 (&v)[4]) {
#pragma unroll
    for (int j = 0; j < 4; ++j) { const v2u w = *(const GAS v2u*)(p + 4 * lane + 256 * j); v[j] = (f32x4){bf_lo(w.x), bf_hi(w.x), bf_lo(w.y), bf_hi(w.y)}; }
}
__device__ __forceinline__ void store_row_bf16(bf16* p, int lane, const f32x4 (&v)[4]) {
#pragma unroll
    for (int j = 0; j < 4; ++j) { v2u o; o.x = pk2(v[j][0], v[j][1]); o.y = pk2(v[j][2], v[j][3]); *(GAS v2u*)(p + 4 * lane + 256 * j) = o; }
}
__device__ __forceinline__ void mod_ln_row(const f32x4 (&x)[4], const float* sh, const float* sc, int lane, f32x4 (&u)[4]) {
    float mean, rstd; ln_stats(x, mean, rstd);
#pragma unroll
    for (int j = 0; j < 4; ++j) { const f32x4 s1 = *(const GAS f32x4*)(sc + 4 * lane + 256 * j), s0 = *(const GAS f32x4*)(sh + 4 * lane + 256 * j); u[j] = (x[j] - mean) * rstd * (1.0f + s1) + s0; }
}
__device__ __forceinline__ void p_r0(const Args& a, int gw, int NGW, int lane) {
    const float* mods = (const float*)(a.ws + WS_MODS); bf16* U = (bf16*)(a.ws + WS_U);
    for (int t0 = gw * 4; t0 < T; t0 += NGW * 4) { const int b = t0 / SEQ; const float* mb = mods + (size_t)b * 6 * D;
        f32x4 x[4][4]; float mean[4], rstd[4];
#pragma unroll
        for (int r = 0; r < 4; ++r) load_row4(a.in[I_X] + (size_t)(t0 + r) * D, lane, x[r]);
#pragma unroll
        for (int r = 0; r < 4; ++r) ln_stats(x[r], mean[r], rstd[r]);
#pragma unroll
        for (int j = 0; j < 4; ++j) { const f32x4 s1 = *(const GAS f32x4*)(mb + D + 4 * lane + 256 * j), s0 = *(const GAS f32x4*)(mb + 4 * lane + 256 * j);
#pragma unroll
            for (int r = 0; r < 4; ++r) { const f32x4 u = (x[r][j] - mean[r]) * rstd[r] * (1.0f + s1) + s0; v2u o; o.x = pk2(u[0], u[1]); o.y = pk2(u[2], u[3]); *(GAS v2u*)(U + (size_t)(t0 + r) * D + 4 * lane + 256 * j) = o; } }
    }
}

namespace att {
typedef short v4i16_t __attribute__((ext_vector_type(4)));
__device__ __forceinline__ s16x4 vtr(const LAS unsigned char* p) { return __builtin_bit_cast(s16x4, __builtin_amdgcn_ds_read_tr16_b64_v4i16((LAS v4i16_t*)p)); }
__device__ __forceinline__ void glds16(const void* gsrc, unsigned lds_dst) { unsigned keep;
    asm volatile("s_mov_b32 %0, m0\n\ts_mov_b32 m0, %2\n\ts_nop 0\n\tglobal_load_lds_dwordx4 %1, off\n\ts_mov_b32 m0, %0" : "=&s"(keep) : "v"(gsrc), "s"(lds_dst) : "memory"); }
__device__ __forceinline__ void stage_kb(LAS unsigned char* slot, const bf16* qkv, int b, int h, int dil, int res, int kbk, int wave, int lane) {
#pragma unroll
    for (int i = 0; i < 2; ++i) {
        const int blk8 = 2 * wave + i;
        const int kk = 8 * blk8 + (lane >> 3), pos = lane & 7;
        const int t = res + dil * (128 * kbk + kk);
        const char* rowp = (const char*)qkv + ((size_t)(b * SEQ + t) * NIN + AW + h * HD) * 2;
        const int cK = pos ^ ((kk >> 1) & 7), cV = pos ^ (((kk >> 1) & 3) << 1);
        glds16(rowp + cK * 16, (unsigned)(unsigned long)(slot + blk8 * 1024));
        glds16(rowp + AW * 2 + cV * 16, (unsigned)(unsigned long)(slot + 16384 + blk8 * 1024));
    }
}
__device__ __forceinline__ void load_q(const bf16* qkv, int b, int h, int dil, int res, int n0, int wave, int lane, bf16x8 (&qf)[2]) {
    const int fr = lane & 15, fq = lane >> 4;
    const size_t trow = (size_t)(b * SEQ + res + dil * (n0 + 16 * wave + fr));
    const bf16* qrow = qkv + trow * NIN + h * HD;
#pragma unroll
    for (int s = 0; s < 2; ++s) qf[s] = *(const GAS bf16x8*)(qrow + 32 * s + 8 * fq);
}
__device__ __forceinline__ float mx2(float a, float b) { return __builtin_elementwise_maximum(a, b); }
struct BlkOut { v2u w[4]; float lse; size_t trow; };
template <bool N0  , int PAT>
__device__ __forceinline__ void block(const LAS unsigned char* slotA, const LAS unsigned char* slotB, const bf16x8 (&qf)[2], BlkOut& bo, int b, int dil, int res, int n0, float slope2, int wq, int lane) {
    constexpr int JMIN = PAT == 0 ? 0 : 33, NSTEP = PAT == 0 ? 5 : 4;
    const int fr = lane & 15, fq = lane >> 4;
    const int qi = 16 * wq + fr;
    const size_t trow = (size_t)(b * SEQ + res + dil * (n0 + qi));
    const int kt_lo = N0 ? 4 : (wq >> 1), kt_hi = (16 * wq + 143 - JMIN) >> 5;
    const int sw = (fr >> 1) & 7, kofs0 = fr * 128 + ((fq ^ sw) << 4), kofs1 = fr * 128 + (((4 + fq) ^ sw) << 4);
    const int q4 = fr >> 2, pp = fr & 3, gL = ((2 * fq + (q4 >> 1)) & 3) << 1;
    int vofs[4];
#pragma unroll
    for (int mt = 0; mt < 4; ++mt) vofs[mt] = (4 * fq + q4) * 128 + ((((2 * mt) ^ gL) + (pp >> 1)) << 4) + 8 * (pp & 1);
    f32x4 kb[2], kbF[2], kbL[2];
    { const int dF = qi + 128 - 32 * kt_lo - 4 * fq, dL = qi + 128 - 32 * kt_hi - 4 * fq;
#pragma unroll
      for (int sub = 0; sub < 2; ++sub)
#pragma unroll
        for (int r = 0; r < 4; ++r) { const int dm = (fr - 4 * fq - r) & 15;
            const float ml = PAT == 0 ? (dm == 0 ? 1.5849625007f : ((dm & 3) == 0 ? 1.0f : 0.0f)) : (PAT == 1 ? ((dm & 3) == 0 ? 1.0f : 0.0f) : 0.0f);
            const float k0 = slope2 * (float)(4 * fq + 16 * sub + r) + ml; kb[sub][r] = k0;
            kbF[sub][r] = ((unsigned)(dF - 16 * sub - r - JMIN) > (unsigned)(128 - JMIN)) ? -3.0e38f : k0; kbL[sub][r] = ((unsigned)(dL - 16 * sub - r - JMIN) > (unsigned)(128 - JMIN)) ? -3.0e38f : k0; } }
    float sc[5][2][4]; float m = -3.0e38f;
#pragma unroll
    for (int j = 0; j < (N0 ? 4 : NSTEP); ++j) {
        const int kt = kt_lo + j;
        if (!N0 || kt <= kt_hi) {
            f32x4 s[2];
#define ATT_QK(TAB) do { _Pragma("unroll") for (int sub = 0; sub < 2; ++sub) { \
                const int rb = 32 * kt + 16 * sub; const LAS unsigned char* kp = (rb < 128 ? slotA : slotB) + (rb & 127) * 128; \
                const bf16x8 k0 = *(const LAS bf16x8*)(kp + kofs0), k1 = *(const LAS bf16x8*)(kp + kofs1); \
                s[sub] = __builtin_amdgcn_mfma_f32_16x16x32_bf16(k1, qf[1], __builtin_amdgcn_mfma_f32_16x16x32_bf16(k0, qf[0], TAB[sub], 0, 0, 0), 0, 0, 0); } } while (0)
            if ((!N0 && j == NSTEP - 1) || (N0 && kt == kt_hi)) ATT_QK(kbL); else if (!N0 && j == 0) ATT_QK(kbF); else ATT_QK(kb);
#undef ATT_QK
#pragma unroll
            for (int sub = 0; sub < 2; ++sub)
#pragma unroll
                for (int r = 0; r < 4; ++r) sc[j][sub][r] = s[sub][r];
            const float off = slope2 * (float)(32 * kt);
            const float mj = mx2(mx2(mx2(sc[j][0][0], sc[j][0][1]), mx2(sc[j][0][2], sc[j][0][3])), mx2(mx2(sc[j][1][0], sc[j][1][1]), mx2(sc[j][1][2], sc[j][1][3])));
            m = mx2(m, mj + off);
        }
    }
    m = mx2(m, __shfl_xor(m, 16)); m = mx2(m, __shfl_xor(m, 32));
    bf16x8 pf[5];
#pragma unroll
    for (int j = 0; j < (N0 ? 4 : NSTEP); ++j) {
        const int kt = kt_lo + j;
        if (!N0 || kt <= kt_hi) {
            const float om = slope2 * (float)(32 * kt) - m; const f32x2 om2 = (f32x2){om, om};
            f32x2 p2[4];
#pragma unroll
            for (int sub = 0; sub < 2; ++sub)
#pragma unroll
                for (int h2 = 0; h2 < 2; ++h2) { const f32x2 a2 = (f32x2){sc[j][sub][2 * h2], sc[j][sub][2 * h2 + 1]} + om2; p2[2 * sub + h2] = (f32x2){ex2(a2[0]), ex2(a2[1])}; }
            v4u pw; pw.x = pk2v(p2[0][0], p2[0][1]); pw.y = pk2v(p2[1][0], p2[1][1]); pw.z = pk2v(p2[2][0], p2[2][1]); pw.w = pk2v(p2[3][0], p2[3][1]);
            pf[j] = __builtin_bit_cast(bf16x8, pw);
        }
    }
    f32x4 o[4], l4 = (f32x4){0.f, 0.f, 0.f, 0.f};
#pragma unroll
    for (int mt = 0; mt < 4; ++mt) o[mt] = (f32x4){0.f, 0.f, 0.f, 0.f};
    const bf16x8 ones = (bf16x8){0x3f80, 0x3f80, 0x3f80, 0x3f80, 0x3f80, 0x3f80, 0x3f80, 0x3f80};
#pragma unroll
    for (int j = 0; j < (N0 ? 4 : NSTEP); ++j) {
        const int kt = kt_lo + j;
        if (!N0 || kt <= kt_hi) {
            const int rb = 32 * kt; const LAS unsigned char* vb = (rb < 128 ? slotA : slotB) + 16384 + (rb & 127) * 128;
            l4 = __builtin_amdgcn_mfma_f32_16x16x32_bf16(ones, pf[j], l4, 0, 0, 0);
#pragma unroll
            for (int mt = 0; mt < 4; ++mt) {
                const s16x4 lo = vtr(vb + vofs[mt]), hi = vtr(vb + vofs[mt] + 2048);
                const bf16x8 vf = __builtin_shufflevector(lo, hi, 0, 1, 2, 3, 4, 5, 6, 7);
                o[mt] = __builtin_amdgcn_mfma_f32_16x16x32_bf16(vf, pf[j], o[mt], 0, 0, 0);
            }
        }
    }
    const float l = l4[0], inv = l > 0.f ? 1.0f / l : 0.f;
#pragma unroll
    for (int mt = 0; mt < 4; ++mt) { bo.w[mt].x = pk2(o[mt][0] * inv, o[mt][1] * inv); bo.w[mt].y = pk2(o[mt][2] * inv, o[mt][3] * inv); }
    bo.lse = l > 0.f ? m + __builtin_amdgcn_logf(l) - slope2 * (float)(128 + qi) : -3.0e38f; bo.trow = trow;
}
__device__ __forceinline__ void store_out(const BlkOut& bo, bf16* outp, float* lsep, int h, int lane) {
    const int fq = lane >> 4; bf16* orow = outp + bo.trow * AW + h * HD + 4 * fq;
#pragma unroll
    for (int mt = 0; mt < 4; ++mt) *(GAS v2u*)(orow + 16 * mt) = bo.w[mt];
    if (fq == 0) lsep[bo.trow * NH + h] = bo.lse;
}
template <int PAT> __device__ __forceinline__ void ticket_p(LAS unsigned char* lds, const Args& a, int tk, int wave, int lane) {
    const bf16* qkv = (const bf16*)(a.ws + WS_QKV);
    constexpr int patt = PAT; const int bh = tk / 6, rem = tk % 6, half = rem & 1, b = bh / NH, h = bh % NH;
    const int dil = patt == 0 ? 1 : (patt == 1 ? 4 : 16);
    const float slope = h < 8 ? exp2f(-(float)(h + 1)) : exp2f(-(0.5f + (float)(h - 8)));
    const float slope2 = slope * (float)dil * LOG2E;
    bf16* outp = (bf16*)(a.ws + WS_ATTP) + (size_t)patt * T * AW; float* lsep = (float*)(a.ws + WS_LSE) + (size_t)patt * T * NH;
    const int e0 = (patt == 0 && half == 1) ? 1 : 0, NL = 8 + e0;
    int res, qb, kres, kbk;
#define ATT_VMW "s_waitcnt vmcnt(4)"
#define ATT_DESC(j) do { if (patt == 0) { res = 0; qb = 8 * half + (j); } else if (patt == 1) { res = 2 * half + ((j) >> 2); qb = (j) & 3; } else { res = 8 * half + (j); qb = 0; } } while (0)
#define ATT_LOAD(i) do { if (patt == 0) { kres = 0; kbk = 8 * half - e0 + (i); } else if (patt == 1) { kres = 2 * half + ((i) >> 2); kbk = (i) & 3; } else { kres = 8 * half + (i); kbk = 0; } \
        stage_kb(lds + ((i) & 3) * 32768, qkv, b, h, dil, kres, kbk, wave, lane); } while (0)
    for (int i = 0; i <= e0 + 1; ++i) ATT_LOAD(i);
    bf16x8 qn[2]; ATT_DESC(0); load_q(qkv, b, h, dil, res, 128 * qb, wave, lane, qn);
    BlkOut bo; bool have_out = false, dma_last = true;
    for (int j = 0; j < 8; ++j) {
        int lane_o = lane; asm volatile("" : "+v"(lane_o));
        const int ib = j + e0;
        if (dma_last) asm volatile(ATT_VMW ::: "memory"); else asm volatile("s_waitcnt vmcnt(0)" ::: "memory");
        __syncthreads();
        bf16x8 qf[2] = {qn[0], qn[1]};
        ATT_DESC(j); const int res_j = res, qb_j = qb;
        if (have_out) store_out(bo, outp, lsep, h, lane_o);
        if (j + 1 < 8) { ATT_DESC(j + 1); load_q(qkv, b, h, dil, res, 128 * qb, wave, lane_o, qn); }
        asm volatile("" ::: "memory");
        if (ib + 2 < NL) { ATT_LOAD(ib + 2); dma_last = true; } else dma_last = false;
        asm volatile("" ::: "memory");
        const LAS unsigned char* sA = lds + ((ib + 3) & 3) * 32768; const LAS unsigned char* sB = lds + (ib & 3) * 32768;
        if constexpr (PAT == 2) block<true, 2>(sA, sB, qf, bo, b, dil, res_j, 0, slope2, wave, lane_o);
        else { if (qb_j == 0) block<true, PAT>(sA, sB, qf, bo, b, dil, res_j, 0, slope2, wave, lane_o); else block<false, PAT>(sA, sB, qf, bo, b, dil, res_j, 128 * qb_j, slope2, wave, lane_o); }
        have_out = true;
    }
    store_out(bo, outp, lsep, h, lane);
#undef ATT_DESC
#undef ATT_LOAD
}
__device__ __forceinline__ void ticket_p2(LAS unsigned char* lds, const Args& a, int tk, int wave, int lane) {
    const bf16* qkv = (const bf16*)(a.ws + WS_QKV);
    const int bh = tk / 6, half = (tk % 6) & 1, b = bh / NH, h = bh % NH;
    constexpr int dil = 16;
    const float slope = h < 8 ? exp2f(-(float)(h + 1)) : exp2f(-(0.5f + (float)(h - 8)));
    const float slope2 = slope * (float)dil * LOG2E;
    bf16* outp = (bf16*)(a.ws + WS_ATTP) + (size_t)2 * T * AW; float* lsep = (float*)(a.ws + WS_LSE) + (size_t)2 * T * NH;
    const int sel = wave & 1, pr = wave >> 1, g1 = 7 - pr, g2 = pr; const bool two = pr >= 2;
    stage_kb(lds, qkv, b, h, dil, 8 * half, 0, wave, lane); stage_kb(lds + 32768, qkv, b, h, dil, 8 * half + 1, 0, wave, lane);
    bf16x8 qn1[2], qn2[2]; load_q(qkv, b, h, dil, 8 * half + sel, 0, g1, lane, qn1); load_q(qkv, b, h, dil, 8 * half + sel, 0, g2, lane, qn2);
    BlkOut bo1, bo2; bool have_out = false;
    for (int s = 0; s < 4; ++s) {
        int lane_o = lane; asm volatile("" : "+v"(lane_o));
        asm volatile("s_waitcnt vmcnt(0)" ::: "memory");
        __syncthreads();
        bf16x8 qf1[2] = {qn1[0], qn1[1]}, qf2[2] = {qn2[0], qn2[1]};
        const int res = 8 * half + 2 * s + sel;
        if (have_out) { store_out(bo1, outp, lsep, h, lane_o); store_out(bo2, outp, lsep, h, lane_o); }
        if (s + 1 < 4) { load_q(qkv, b, h, dil, res + 2, 0, g1, lane_o, qn1); load_q(qkv, b, h, dil, res + 2, 0, g2, lane_o, qn2);
            asm volatile("" ::: "memory");
            stage_kb(lds + ((2 * s + 2) & 3) * 32768, qkv, b, h, dil, 8 * half + 2 * s + 2, 0, wave, lane_o); stage_kb(lds + ((2 * s + 3) & 3) * 32768, qkv, b, h, dil, 8 * half + 2 * s + 3, 0, wave, lane_o); }
        asm volatile("" ::: "memory");
        const LAS unsigned char* slot = lds + ((2 * s + sel) & 3) * 32768;
        block<true, 2>(slot, slot, qf1, bo1, b, dil, res, 0, slope2, g1, lane_o);
        if (two) block<true, 2>(slot, slot, qf2, bo2, b, dil, res, 0, slope2, g2, lane_o);
        else { bo2.w[0] = bo2.w[1] = bo2.w[2] = bo2.w[3] = (v2u){0u, 0u}; bo2.lse = -3.0e38f; bo2.trow = (size_t)(b * SEQ + res + dil * (16 * g2 + (lane_o & 15))); }
        have_out = true;
    }
    store_out(bo1, outp, lsep, h, lane); store_out(bo2, outp, lsep, h, lane);
}
__device__ __forceinline__ void ticket(LAS unsigned char* lds, const Args& a, int tk, int wave, int lane) {
    const int patt = (tk % 6) >> 1;
    if (patt == 0) ticket_p<0>(lds, a, tk, wave, lane); else if (patt == 1) ticket_p<1>(lds, a, tk, wave, lane); else ticket_p2(lds, a, tk, wave, lane);
}
}
namespace lru {
constexpr int XC_OFF = 0, XCF_OFF = 16384, XG_OFF = XCF_OFF + 128 * 68 * 4, OUT_OFF = XG_OFF + 128 * 72 * 2, AGG_OFF = OUT_OFF + 128 * 72 * 2, WF_OFF = AGG_OFF + 4096, CWL_OFF = WF_OFF + 16384;
static_assert(CWL_OFF + 1280 <= RING_BYTES, "lru lds");
__device__ __forceinline__ void unit(LAS unsigned char* lds, const Args& a, int l, int tk, int wave, int lane, int tid) {
    const int b = tk >> 2, blk = tk & 3, fr = lane & 15, fq = lane >> 4;
    const bf16* qkv = (const bf16*)(a.ws + WS_QKV); bf16* outg = (bf16*)(a.ws + WS_LRU);
    LAS v4u* WF = (LAS v4u*)(lds + WF_OFF);
    {
#pragma unroll
      for (int ff = 0; ff < 2; ++ff) { const int f = 2 * wave + ff, gate = f >> 3, nt = (f >> 1) & 3, s = f & 1;
        const float* W = (gate ? a.in[I_WX] : a.in[I_WA]) + ((size_t)l * 4 + blk) * 64 * 64;
        const int k0 = 32 * s + 8 * fq, oc = 16 * nt + fr; v4u pa;
        pa.x = pk2(W[(k0 + 0) * 64 + oc], W[(k0 + 1) * 64 + oc]); pa.y = pk2(W[(k0 + 2) * 64 + oc], W[(k0 + 3) * 64 + oc]); pa.z = pk2(W[(k0 + 4) * 64 + oc], W[(k0 + 5) * 64 + oc]); pa.w = pk2(W[(k0 + 6) * 64 + oc], W[(k0 + 7) * 64 + oc]);
        WF[f * 64 + lane] = pa; } }
    float ba[4], bx[4], csp[4], carry[4];
#pragma unroll
    for (int nt = 0; nt < 4; ++nt) { const int ch = l * LW + 64 * blk + 16 * nt + fr; ba[nt] = a.in[I_BA][ch]; bx[nt] = a.in[I_BX][ch]; csp[nt] = 8.0f * log1pf(expf(-a.in[I_LAM][ch])); carry[nt] = 0.f; }
    const int c8 = tid & 7, chb = 64 * blk + 8 * c8;
    LAS unsigned char* XC = lds + XC_OFF; LAS float* XCF = (LAS float*)(lds + XCF_OFF); LAS bf16* XG = (LAS bf16*)(lds + XG_OFF); LAS bf16* OUT = (LAS bf16*)(lds + OUT_OFF); LAS float* AGG = (LAS float*)(lds + AGG_OFF);
    LAS float* CWL = (LAS float*)(lds + CWL_OFF);
    if (tid < 320) { const int j = tid >> 6, ch = tid & 63; CWL[tid] = j < 4 ? a.in[I_CONVW][((size_t)l * 4 + j) * LW + 64 * blk + ch] : a.in[I_CONVB][l * LW + 64 * blk + ch]; }
    __syncthreads();
    v4u px[5], pg[2];
#define LRU_FETCH(tile_) do { const int s0 = 128 * (tile_) + 2 * (tid >> 3); const bf16* rowp = qkv + (size_t)(b * SEQ + s0) * NIN + 2304 + chb; \
        _Pragma("unroll") for (int k = 0; k < 5; ++k) { px[k] = (v4u){0u, 0u, 0u, 0u}; if (s0 - 3 + k >= 0) px[k] = *(const GAS v4u*)(rowp + ((ptrdiff_t)k - 3) * NIN); } \
        pg[0] = *(const GAS v4u*)(rowp + LW); pg[1] = *(const GAS v4u*)(rowp + NIN + LW); } while (0)
    LRU_FETCH(0);
    for (int tile = 0; tile < 16; ++tile) {
#pragma unroll
        for (int it = 0; it < 2; ++it) {
            const int ti = 2 * (tid >> 3) + it;
            float xc[8];
            { const f32x4 c0 = *(const LAS f32x4*)(CWL + 256 + 8 * c8), c1 = *(const LAS f32x4*)(CWL + 256 + 8 * c8 + 4); xc[0] = c0[0]; xc[1] = c0[1]; xc[2] = c0[2]; xc[3] = c0[3]; xc[4] = c1[0]; xc[5] = c1[1]; xc[6] = c1[2]; xc[7] = c1[3]; }
#pragma unroll
            for (int j = 0; j < 4; ++j) { const v4u xr = px[it + j]; const f32x4 w0 = *(const LAS f32x4*)(CWL + 64 * j + 8 * c8), w1 = *(const LAS f32x4*)(CWL + 64 * j + 8 * c8 + 4);
                xc[0] += w0[0] * bf_lo(xr.x); xc[1] += w0[1] * bf_hi(xr.x); xc[2] += w0[2] * bf_lo(xr.y); xc[3] += w0[3] * bf_hi(xr.y);
                xc[4] += w1[0] * bf_lo(xr.z); xc[5] += w1[1] * bf_hi(xr.z); xc[6] += w1[2] * bf_lo(xr.w); xc[7] += w1[3] * bf_hi(xr.w); }
            v4u xb; xb.x = pk2(xc[0], xc[1]); xb.y = pk2(xc[2], xc[3]); xb.z = pk2(xc[4], xc[5]); xb.w = pk2(xc[6], xc[7]);
            *(LAS v4u*)(XC + ti * 128 + ((c8 ^ ((ti >> 1) & 7)) << 4)) = xb;
            *(LAS f32x4*)(XCF + ti * 68 + 8 * c8) = (f32x4){xc[0], xc[1], xc[2], xc[3]}; *(LAS f32x4*)(XCF + ti * 68 + 8 * c8 + 4) = (f32x4){xc[4], xc[5], xc[6], xc[7]};
            *(LAS v4u*)(XG + ti * 72 + 8 * c8) = pg[it];
        }
        if (tile + 1 < 16) LRU_FETCH(tile + 1);
        __syncthreads();
        f32x4 ga[4], gx[4];
        { const int tok = 16 * wave + fr, sw = (tok >> 1) & 7;
          const bf16x8 a0 = *(const LAS bf16x8*)(XC + tok * 128 + ((fq ^ sw) << 4)), a1 = *(const LAS bf16x8*)(XC + tok * 128 + (((4 + fq) ^ sw) << 4));
#pragma unroll
          for (int nt = 0; nt < 4; ++nt) { f32x4 z = (f32x4){0.f, 0.f, 0.f, 0.f};
              const bf16x8 wa0 = __builtin_bit_cast(bf16x8, WF[(nt * 2 + 0) * 64 + lane]), wa1 = __builtin_bit_cast(bf16x8, WF[(nt * 2 + 1) * 64 + lane]);
              const bf16x8 wx0 = __builtin_bit_cast(bf16x8, WF[(8 + nt * 2 + 0) * 64 + lane]), wx1 = __builtin_bit_cast(bf16x8, WF[(8 + nt * 2 + 1) * 64 + lane]);
              ga[nt] = __builtin_amdgcn_mfma_f32_16x16x32_bf16(a1, wa1, __builtin_amdgcn_mfma_f32_16x16x32_bf16(a0, wa0, z, 0, 0, 0), 0, 0, 0);
              gx[nt] = __builtin_amdgcn_mfma_f32_16x16x32_bf16(a1, wx1, __builtin_amdgcn_mfma_f32_16x16x32_bf16(a0, wx0, z, 0, 0, 0), 0, 0, 0); } }
        float av[4][4], bv[4][4], Aex[4], Hex[4];
#pragma unroll
        for (int nt = 0; nt < 4; ++nt) {
            const int ch = 16 * nt + fr; float A4 = 1.f, H4 = 0.f;
#pragma unroll
            for (int r = 0; r < 4; ++r) { const int tok2 = 16 * wave + 4 * fq + r;
                const float rg = sigmoidf_(ga[nt][r] + ba[nt]), ig = sigmoidf_(gx[nt][r] + bx[nt]);
                const float la = -csp[nt] * rg, x2 = 2.0f * la, aa = ex2(la * LOG2E);
                const float ser = -x2 * (1.0f + x2 * (0.5f + x2 * (0.16666667f + x2 * (0.041666668f + x2 * 0.0083333338f))));
                const float om = (x2 > -0.3f) ? ser : (1.0f - aa * aa);
                const float bb = __builtin_amdgcn_sqrtf(om) * ig * XCF[tok2 * 68 + ch];
                av[nt][r] = aa; bv[nt][r] = bb; H4 = aa * H4 + bb; A4 *= aa; }
            float Ap = __shfl_up(A4, 16), Hp = __shfl_up(H4, 16); if (fq >= 1) { H4 = A4 * Hp + H4; A4 = A4 * Ap; }
            Ap = __shfl_up(A4, 32); Hp = __shfl_up(H4, 32); if (fq >= 2) { H4 = A4 * Hp + H4; A4 = A4 * Ap; }
            Aex[nt] = __shfl_up(A4, 16); Hex[nt] = __shfl_up(H4, 16); if (fq == 0) { Aex[nt] = 1.f; Hex[nt] = 0.f; }
            if (fq == 3) { AGG[(wave * 64 + ch) * 2] = A4; AGG[(wave * 64 + ch) * 2 + 1] = H4; }
        }
        __syncthreads();
#pragma unroll
        for (int nt = 0; nt < 4; ++nt) {
            const int ch = 16 * nt + fr; float h = carry[nt], hw = carry[nt];
#pragma unroll
            for (int w2 = 0; w2 < 8; ++w2) { if (w2 == wave) hw = h; const float A = AGG[(w2 * 64 + ch) * 2], H = AGG[(w2 * 64 + ch) * 2 + 1]; h = A * h + H; }
            carry[nt] = h;
            float hl = Aex[nt] * hw + Hex[nt];
#pragma unroll
            for (int r = 0; r < 4; ++r) { const int tok2 = 16 * wave + 4 * fq + r; hl = av[nt][r] * hl + bv[nt][r];
                const float g = __builtin_bit_cast(float, (unsigned)XG[tok2 * 72 + ch] << 16);
                const float y = hl * g * sigmoidf_(1.5957691216f * (g + 0.044715f * g * g * g));
                OUT[tok2 * 72 + ch] = (bf16)f2bf(y); }
        }
        __syncthreads();
#pragma unroll
        for (int it = 0; it < 2; ++it) { const int ti = (tid >> 3) + 64 * it, s = 128 * tile + ti;
            *(GAS v4u*)(outg + (size_t)(b * SEQ + s) * LW + chb) = *(const LAS v4u*)(OUT + ti * 72 + 8 * c8); }
    }
#undef LRU_FETCH
}
}

__device__ __forceinline__ void merge_chunk(const bf16* ATTP, const float* LSE, int t, int c, float (&v)[8]) {
    const int head = c >> 3;
    const float l0 = LSE[(size_t)t * NH + head], l1 = LSE[(size_t)T * NH + (size_t)t * NH + head], l2 = LSE[(size_t)2 * T * NH + (size_t)t * NH + head];
    const float mx = fmaxf(l0, fmaxf(l1, l2)); float w0 = ex2(l0 - mx), w1 = ex2(l1 - mx), w2 = ex2(l2 - mx); const float inv = 1.0f / (w0 + w1 + w2); w0 *= inv; w1 *= inv; w2 *= inv;
    const v4u p0 = *(const GAS v4u*)(ATTP + (size_t)t * AW + 8 * c), p1 = *(const GAS v4u*)(ATTP + (size_t)T * AW + (size_t)t * AW + 8 * c), p2 = *(const GAS v4u*)(ATTP + (size_t)2 * T * AW + (size_t)t * AW + 8 * c);
    v[0] = w0 * bf_lo(p0.x) + w1 * bf_lo(p1.x) + w2 * bf_lo(p2.x); v[1] = w0 * bf_hi(p0.x) + w1 * bf_hi(p1.x) + w2 * bf_hi(p2.x);
    v[2] = w0 * bf_lo(p0.y) + w1 * bf_lo(p1.y) + w2 * bf_lo(p2.y); v[3] = w0 * bf_hi(p0.y) + w1 * bf_hi(p1.y) + w2 * bf_hi(p2.y);
    v[4] = w0 * bf_lo(p0.z) + w1 * bf_lo(p1.z) + w2 * bf_lo(p2.z); v[5] = w0 * bf_hi(p0.z) + w1 * bf_hi(p1.z) + w2 * bf_hi(p2.z);
    v[6] = w0 * bf_lo(p0.w) + w1 * bf_lo(p1.w) + w2 * bf_lo(p2.w); v[7] = w0 * bf_hi(p0.w) + w1 * bf_hi(p1.w) + w2 * bf_hi(p2.w);
}
constexpr int MRG = 2;
__device__ __forceinline__ void p_merge(const Args& a, int l, int gw, int NGW, int lane) {
    const bf16* ATTP = (const bf16*)(a.ws + WS_ATTP); const float* LSE = (const float*)(a.ws + WS_LSE); const bf16* LRU = (const bf16*)(a.ws + WS_LRU); bf16* A2 = (bf16*)(a.ws + WS_U);
    const float* ang = a.in[I_ANG] + l * AW; const float* lng = a.in[I_LNG] + l * LW;
    const bool at1 = lane < 32;
    const float* g0 = ang + 8 * lane; const float* g1 = at1 ? ang + 512 + 8 * lane : lng + 8 * (lane - 32);
    float gg0[8], gg1[8];
#pragma unroll
    for (int k = 0; k < 8; ++k) { gg0[k] = g0[k]; gg1[k] = g1[k]; }
    for (int t0 = gw * MRG; t0 < T; t0 += NGW * MRG) {
        float v0[MRG][8], v1[MRG][8];
#pragma unroll
        for (int r = 0; r < MRG; ++r) { const int t = t0 + r;
            merge_chunk(ATTP, LSE, t, lane, v0[r]);
            if (at1) merge_chunk(ATTP, LSE, t, 64 + lane, v1[r]);
            else { const v4u p = *(const GAS v4u*)(LRU + (size_t)t * LW + 8 * (lane - 32)); v1[r][0] = bf_lo(p.x); v1[r][1] = bf_hi(p.x); v1[r][2] = bf_lo(p.y); v1[r][3] = bf_hi(p.y); v1[r][4] = bf_lo(p.z); v1[r][5] = bf_hi(p.z); v1[r][6] = bf_lo(p.w); v1[r][7] = bf_hi(p.w); } }
#pragma unroll
        for (int r = 0; r < MRG; ++r) { const int t = t0 + r;
            float s0 = 0.f, s1 = 0.f;
#pragma unroll
            for (int k = 0; k < 8; ++k) { s0 += v0[r][k] * v0[r][k]; s1 += v1[r][k] * v1[r][k]; }
            const float ssa = wave_sum(s0 + (at1 ? s1 : 0.f)), ssl = wave_sum(at1 ? 0.f : s1);
            const float ra = rsqrtf(ssa * (1.0f / AW) + RMS_EPS), rl = rsqrtf(ssl * (1.0f / LW) + RMS_EPS); const float r1 = at1 ? ra : rl;
            v4u o0, o1;
            o0.x = pk2(v0[r][0] * ra * gg0[0], v0[r][1] * ra * gg0[1]); o0.y = pk2(v0[r][2] * ra * gg0[2], v0[r][3] * ra * gg0[3]); o0.z = pk2(v0[r][4] * ra * gg0[4], v0[r][5] * ra * gg0[5]); o0.w = pk2(v0[r][6] * ra * gg0[6], v0[r][7] * ra * gg0[7]);
            o1.x = pk2(v1[r][0] * r1 * gg1[0], v1[r][1] * r1 * gg1[1]); o1.y = pk2(v1[r][2] * r1 * gg1[2], v1[r][3] * r1 * gg1[3]); o1.z = pk2(v1[r][4] * r1 * gg1[4], v1[r][5] * r1 * gg1[5]); o1.w = pk2(v1[r][6] * r1 * gg1[6], v1[r][7] * r1 * gg1[7]);
            *(GAS v4u*)(A2 + (size_t)t * D + 8 * lane) = o0; *(GAS v4u*)(A2 + (size_t)t * D + 512 + 8 * lane) = o1; }
    }
}

typedef _Float16 f16x8 __attribute__((ext_vector_type(8)));
typedef __fp16 h16x2 __attribute__((ext_vector_type(2)));
constexpr int R2_UH = 0, R2_UL = 32768, R2_PART = 65536, R2_LOG = 81920, R2_PAR = 83968;
__device__ __forceinline__ float row16_max(float v) { v = fmaxf(v, dpp_f<0xB1>(v)); v = fmaxf(v, dpp_f<0x4E>(v)); v = fmaxf(v, dpp_f<0x141>(v)); v = fmaxf(v, dpp_f<0x140>(v)); return v; }
__device__ __forceinline__ void p_r2(const Args& a, LAS unsigned char* lds, volatile LAS unsigned* MISC, int l, int wg, int G, int wave, int lane, int tid) {
    const int fr = lane & 15, fq = lane >> 4;
    f16x8 bh[4][2], bl[4][2];
    { const float* rw = a.in[I_RW] + (size_t)l * D * NE;
#pragma unroll
      for (int s = 0; s < 4; ++s)
#pragma unroll
        for (int nt = 0; nt < 2; ++nt)
#pragma unroll
            for (int j = 0; j < 8; ++j) { const float w = rw[(size_t)(32 * (4 * wave + s) + 8 * fq + j) * NE + 16 * nt + fr]; const _Float16 hi = (_Float16)w; bh[s][nt][j] = hi; bl[s][nt][j] = (_Float16)(w - (float)hi); } }
    const float* mods = (const float*)(a.ws + WS_MODS); const float* xin = a.in[I_X]; const bf16* xbf = (const bf16*)(a.ws + WS_X);
    const bf16* MIX = (const bf16*)(a.ws + WS_MIX); bf16* X1 = (bf16*)(a.ws + WS_X1); unsigned char* U8 = a.ws + WS_U8;
    int* TOPI = (int*)(a.ws + WS_TOPI); float* TOPW = (float*)(a.ws + WS_TOPW); unsigned* WGB = (unsigned*)(a.ws + WS_WGB);
    unsigned* etot = (unsigned*)(a.ws + WS_CTL) + CW_ETOT + 64 * l;
    const float* l1g = a.in[I_LN1G] + l * D; const float* l1b = a.in[I_LN1B] + l * D; const float rbias = a.in[I_RB][l * NE + (tid & 31)];
    LAS float* PART = (LAS float*)(lds + R2_PART); LAS float* LOG = (LAS float*)(lds + R2_LOG);
    for (int chunk = wg; chunk < T / 256; chunk += G) {
        if (tid < 32) MISC[MW_HIST + tid] = 0u;
        { const int bch = (256 * chunk) / SEQ; const float* mbc = mods + ((size_t)l * BATCH + bch) * 6 * D; LAS f32x4* PV = (LAS f32x4*)(lds + R2_PAR);
          for (int i = tid; i < 5 * 256; i += 512) { const int v = i >> 8, q = i & 255; const float* src = v == 0 ? mbc + 2 * D : v == 1 ? l1g : v == 2 ? l1b : v == 3 ? mbc + 4 * D : mbc + 3 * D; PV[i] = *(const GAS f32x4*)(src + 4 * q); } }
        __syncthreads();
        v2u xpre[2][4], mpre[2][4];
#pragma unroll
        for (int r = 0; r < 2; ++r)
#pragma unroll
            for (int j = 0; j < 4; ++j) { const size_t o = (size_t)(256 * chunk + 2 * wave + r) * D + 4 * lane + 256 * j; mpre[r][j] = *(const GAS v2u*)(MIX + o); xpre[r][j] = (l != 0) ? *(const GAS v2u*)(xbf + o) : (v2u){0u, 0u}; }
        for (int it = 0; it < 16; ++it) {
            const int tb = 256 * chunk + 16 * it, t0 = tb + 2 * wave, b = t0 / SEQ; const float* mb = mods + ((size_t)l * BATCH + b) * 6 * D;
            f32x4 x[2][4], u[2][4]; v2u mw[2][4];
#pragma unroll
            for (int r = 0; r < 2; ++r) {
                if (l == 0) load_row4(xin + (size_t)(t0 + r) * D, lane, x[r]);
                else {
#pragma unroll
                    for (int j = 0; j < 4; ++j) x[r][j] = (f32x4){bf_lo(xpre[r][j].x), bf_hi(xpre[r][j].x), bf_lo(xpre[r][j].y), bf_hi(xpre[r][j].y)}; }
#pragma unroll
                for (int j = 0; j < 4; ++j) mw[r][j] = mpre[r][j]; }
            if (it + 1 < 16) {
#pragma unroll
                for (int r = 0; r < 2; ++r)
#pragma unroll
                    for (int j = 0; j < 4; ++j) { mpre[r][j] = *(const GAS v2u*)(MIX + (size_t)(t0 + 16 + r) * D + 4 * lane + 256 * j); if (l != 0) xpre[r][j] = *(const GAS v2u*)(xbf + (size_t)(t0 + 16 + r) * D + 4 * lane + 256 * j); } }
#pragma unroll
            for (int j = 0; j < 4; ++j) { const f32x4 g1 = *(const LAS f32x4*)(lds + R2_PAR + (0 * 256 + lane + 64 * j) * 16);
#pragma unroll
                for (int r = 0; r < 2; ++r) { const f32x4 mx = (f32x4){bf_lo(mw[r][j].x), bf_hi(mw[r][j].x), bf_lo(mw[r][j].y), bf_hi(mw[r][j].y)}; x[r][j] = ALPHA * x[r][j] + (1.0f + g1) * mx; } }
            float mean[2], rstd[2];
#pragma unroll
            for (int r = 0; r < 2; ++r) ln_stats(x[r], mean[r], rstd[r]);
#pragma unroll
            for (int j = 0; j < 4; ++j) { const f32x4 g = *(const LAS f32x4*)(lds + R2_PAR + (1 * 256 + lane + 64 * j) * 16), bb = *(const LAS f32x4*)(lds + R2_PAR + (2 * 256 + lane + 64 * j) * 16);
#pragma unroll
                for (int r = 0; r < 2; ++r) { x[r][j] = (x[r][j] - mean[r]) * rstd[r] * g + bb; v2u o; o.x = pk2(x[r][j][0], x[r][j][1]); o.y = pk2(x[r][j][2], x[r][j][3]); *(GAS v2u*)(X1 + (size_t)(t0 + r) * D + 4 * lane + 256 * j) = o; } }
#pragma unroll
            for (int r = 0; r < 2; ++r) ln_stats(x[r], mean[r], rstd[r]);
#pragma unroll
            for (int j = 0; j < 4; ++j) { const f32x4 s1 = *(const LAS f32x4*)(lds + R2_PAR + (3 * 256 + lane + 64 * j) * 16), s0 = *(const LAS f32x4*)(lds + R2_PAR + (4 * 256 + lane + 64 * j) * 16);
#pragma unroll
                for (int r = 0; r < 2; ++r) { u[r][j] = (x[r][j] - mean[r]) * rstd[r] * (1.0f + s1) + s0;
                    *(GAS unsigned*)(U8 + (size_t)(t0 + r) * D + 4 * lane + 256 * j) = pk4_fp8(u[r][j][0] * F8_SA1, u[r][j][1] * F8_SA1, u[r][j][2] * F8_SA1, u[r][j][3] * F8_SA1);
                    const h16x2 h0 = __builtin_amdgcn_cvt_pkrtz(u[r][j][0], u[r][j][1]), h1 = __builtin_amdgcn_cvt_pkrtz(u[r][j][2], u[r][j][3]);
                    const h16x2 l0 = __builtin_amdgcn_cvt_pkrtz(u[r][j][0] - (float)h0[0], u[r][j][1] - (float)h0[1]), l1 = __builtin_amdgcn_cvt_pkrtz(u[r][j][2] - (float)h1[0], u[r][j][3] - (float)h1[1]);
                    const int row = 2 * wave + r, off = row * 2048 + ((((lane >> 1) + 32 * j) ^ (row & 15)) << 4) + 8 * (lane & 1);
                    *(LAS v2u*)(lds + R2_UH + off) = (v2u){__builtin_bit_cast(unsigned, h0), __builtin_bit_cast(unsigned, h1)};
                    *(LAS v2u*)(lds + R2_UL + off) = (v2u){__builtin_bit_cast(unsigned, l0), __builtin_bit_cast(unsigned, l1)}; } }
            __syncthreads();
            f32x4 acc[2] = {(f32x4){0.f, 0.f, 0.f, 0.f}, (f32x4){0.f, 0.f, 0.f, 0.f}};
#pragma unroll
            for (int s = 0; s < 4; ++s) { const int off = fr * 2048 + (((4 * (4 * wave + s) + fq) ^ fr) << 4);
                const f16x8 ah = *(const LAS f16x8*)(lds + R2_UH + off), al = *(const LAS f16x8*)(lds + R2_UL + off);
#pragma unroll
                for (int nt = 0; nt < 2; ++nt) { acc[nt] = __builtin_amdgcn_mfma_f32_16x16x32_f16(ah, bh[s][nt], acc[nt], 0, 0, 0); acc[nt] = __builtin_amdgcn_mfma_f32_16x16x32_f16(ah, bl[s][nt], acc[nt], 0, 0, 0);
                    acc[nt] = __builtin_amdgcn_mfma_f32_16x16x32_f16(al, bh[s][nt], acc[nt], 0, 0, 0); } }
#pragma unroll
            for (int nt = 0; nt < 2; ++nt)
#pragma unroll
                for (int r = 0; r < 4; ++r) PART[(wave * 16 + 4 * fq + r) * 32 + 16 * nt + fr] = acc[nt][r];
            __syncthreads();
            { float sgm = rbias;
#pragma unroll
              for (int w = 0; w < 8; ++w) sgm += PART[(w * 16 + (tid >> 5)) * 32 + (tid & 31)];
              LOG[tid] = sgm; }
            __syncthreads();
            { const int half = lane >> 5, ee = lane & 31; float lg = LOG[(2 * wave + half) * 32 + ee];
              int si[4]; float sv[4];
#pragma unroll
              for (int k = 0; k < 4; ++k) { float mx = row16_max(lg); mx = fmaxf(mx, __shfl_xor(mx, 16)); const unsigned long long bal = __ballot(lg == mx);
                  const unsigned bits = half ? (unsigned)(bal >> 32) : (unsigned)bal; si[k] = __ffs((int)bits) - 1; sv[k] = mx; if (ee == si[k]) lg = -3.0e38f; }
              const float e1 = ex2((sv[1] - sv[0]) * LOG2E), e2 = ex2((sv[2] - sv[0]) * LOG2E), e3 = ex2((sv[3] - sv[0]) * LOG2E), inv = 1.0f / (1.0f + e1 + e2 + e3);
              if (ee == 0) { const int t = tb + 2 * wave + half;
                  *(GAS v4i*)(TOPI + (size_t)t * 4) = (v4i){si[0], si[1], si[2], si[3]}; *(GAS f32x4*)(TOPW + (size_t)t * 4) = (f32x4){inv, e1 * inv, e2 * inv, e3 * inv};
#pragma unroll
                  for (int k = 0; k < 4; ++k) __hip_atomic_fetch_add((LAS unsigned*)(MISC + MW_HIST + si[k]), 1u, __ATOMIC_RELAXED, __HIP_MEMORY_SCOPE_WORKGROUP); } }
        }
        __syncthreads();
        if (tid < 32) { const unsigned c = MISC[MW_HIST + tid]; WGB[chunk * 32 + tid] = __hip_atomic_fetch_add(etot + tid, c, RLX_AGENT); }
        __syncthreads();
    }
}
__device__ __forceinline__ int build_tiles(const Args& a, volatile LAS unsigned* MISC, int l, int tid) {
    unsigned* etot = (unsigned*)(a.ws + WS_CTL) + CW_ETOT + 64 * l;
    __syncthreads();
    if (tid == 0) { unsigned acc = 0; for (int e = 0; e < NE; ++e) { MISC[MW_EBASE + e] = acc; const unsigned c = __hip_atomic_load(etot + e, RLX_AGENT); MISC[MW_ETOT + e] = c; acc += ((c + 255u) >> 8) << 8; } MISC[MW_EBASE + NE] = acc; }
    __syncthreads();
    const int ntiles = (int)(MISC[MW_EBASE + NE] >> 8);
    volatile LAS unsigned short* te = (volatile LAS unsigned short*)(MISC + MW_TILEE);
    for (int pm = tid; pm < ntiles; pm += 512) { int e = 0; for (int k = 1; k < NE; ++k) if (MISC[MW_EBASE + k] <= (unsigned)pm * 256u) e = k; te[pm] = (unsigned short)e; }
    __syncthreads();
    return ntiles;
}
__device__ __forceinline__ void p_dispatch(const Args& a, LAS unsigned char* lds, volatile LAS unsigned* MISC, int l, int wg, int G, int wave, int lane, int tid) {
    build_tiles(a, MISC, l, tid);
    const int* TOPI = (const int*)(a.ws + WS_TOPI); int* SLOT = (int*)(a.ws + WS_SLOT); const unsigned* WGB = (const unsigned*)(a.ws + WS_WGB); int* ROWMAP = (int*)(a.ws + WS_ROWMAP);
    for (int e = wg; e < NE; e += G) {
        const unsigned lo = MISC[MW_EBASE + e] + MISC[MW_ETOT + e], hi = MISC[MW_EBASE + e + 1];
        for (unsigned s2 = lo + tid; s2 < hi; s2 += 512) ROWMAP[s2] = 0; }
    for (int chunk = wg; chunk < T / 256; chunk += G) {
        if (tid < 32) { MISC[MW_HIST + tid] = 0u; MISC[MW_WGB + tid] = WGB[chunk * 32 + tid]; }
        __syncthreads();
#pragma unroll
        for (int it = 0; it < 2; ++it) { const int p = tid + 512 * it; const int e = TOPI[(size_t)256 * chunk * 4 + p];
            const unsigned r = __hip_atomic_fetch_add((LAS unsigned*)(MISC + MW_HIST + e), 1u, __ATOMIC_RELAXED, __HIP_MEMORY_SCOPE_WORKGROUP);
            const int slot = (int)(MISC[MW_EBASE + e] + MISC[MW_WGB + e] + r); SLOT[(size_t)256 * chunk * 4 + p] = slot; ROWMAP[slot] = 256 * chunk + (p >> 2); }
        __syncthreads();
    }
}
#ifndef PROJ_WGM
#define PROJ_WGM 8
#endif
#ifndef MOE_WGM
#define MOE_WGM 8
#endif
constexpr int R3N = 2;
__device__ __forceinline__ void p_r3(const Args& a, LAS unsigned char* lds, int l, int wg, int G, int wave, int lane, int tid) {
    const float* mods = (const float*)(a.ws + WS_MODS); const bf16* X1 = (const bf16*)(a.ws + WS_X1); const unsigned char* Z = a.ws + WS_XG;
    const int* SLOT = (const int*)(a.ws + WS_SLOT); const float* TOPW = (const float*)(a.ws + WS_TOPW);
    float* xo = a.out; bf16* xbo = (bf16*)(a.ws + WS_X); bf16* U = (bf16*)(a.ws + WS_U);
    const float* l2g = a.in[I_LN2G] + l * D; const float* l2b = a.in[I_LN2B] + l * D;
    LAS f32x4* PV = (LAS f32x4*)lds;
    for (int chunk = wg; chunk < T / 256; chunk += G) {
        const int b = (256 * chunk) / SEQ; const float* mb = mods + ((size_t)l * BATCH + b) * 6 * D; const float* mn = mods + ((size_t)(l + 1 < DEPTH ? l + 1 : l) * BATCH + b) * 6 * D;
        __syncthreads();
        for (int i = tid; i < 5 * 256; i += 512) { const int v = i >> 8, q = i & 255; const float* src = v == 0 ? mb + 5 * D : v == 1 ? l2g : v == 2 ? l2b : v == 3 ? mn + D : mn; PV[i] = *(const GAS f32x4*)(src + 4 * q); }
        __syncthreads();
        const int tw = 256 * chunk + 32 * wave;
        v4i sl[R3N]; f32x4 wt[R3N];
#pragma unroll
        for (int r = 0; r < R3N; ++r) { sl[r] = *(const GAS v4i*)(SLOT + (size_t)(tw + r) * 4); wt[r] = *(const GAS f32x4*)(TOPW + (size_t)(tw + r) * 4); }
        for (int i = 0; i < 32; i += R3N) {
            const int t0 = tw + i;
            f32x4 f[R3N][4], x[R3N][4]; unsigned z[R3N][4][4];
#pragma unroll
            for (int r = 0; r < R3N; ++r)
#pragma unroll
                for (int k = 0; k < 4; ++k) { const unsigned char* zr = Z + (size_t)sl[r][k] * D;
#pragma unroll
                    for (int j = 0; j < 4; ++j) z[r][k][j] = *(const GAS unsigned*)(zr + 4 * lane + 256 * j); }
#pragma unroll
            for (int r = 0; r < R3N; ++r) load_row4_bf16(X1 + (size_t)(t0 + r) * D, lane, x[r]);
            f32x4 wcur[R3N];
#pragma unroll
            for (int r = 0; r < R3N; ++r) wcur[r] = wt[r];
            if (i + R3N < 32) {
#pragma unroll
                for (int r = 0; r < R3N; ++r) { sl[r] = *(const GAS v4i*)(SLOT + (size_t)(t0 + R3N + r) * 4); wt[r] = *(const GAS f32x4*)(TOPW + (size_t)(t0 + R3N + r) * 4); } }
#pragma unroll
            for (int r = 0; r < R3N; ++r)
#pragma unroll
                for (int j = 0; j < 4; ++j) { f[r][j] = (f32x4){0.f, 0.f, 0.f, 0.f};
#pragma unroll
                    for (int k = 0; k < 4; ++k) { const int w = (int)z[r][k][j]; const f32x2 lo = __builtin_amdgcn_cvt_pk_f32_fp8(w, false), hi = __builtin_amdgcn_cvt_pk_f32_fp8(w, true);
                        f[r][j] += (wcur[r][k] * (1.0f / F8_SZ)) * (f32x4){lo[0], lo[1], hi[0], hi[1]}; } }
#pragma unroll
            for (int j = 0; j < 4; ++j) { const f32x4 g2 = PV[0 * 256 + lane + 64 * j];
#pragma unroll
                for (int r = 0; r < R3N; ++r) x[r][j] = ALPHA * x[r][j] + (1.0f + g2) * f[r][j]; }
            float mean[R3N], rstd[R3N];
#pragma unroll
            for (int r = 0; r < R3N; ++r) ln_stats(x[r], mean[r], rstd[r]);
#pragma unroll
            for (int j = 0; j < 4; ++j) { const f32x4 g = PV[1 * 256 + lane + 64 * j], bb = PV[2 * 256 + lane + 64 * j];
#pragma unroll
                for (int r = 0; r < R3N; ++r) { x[r][j] = (x[r][j] - mean[r]) * rstd[r] * g + bb;
                    if (l == DEPTH - 1) *(GAS f32x4*)(xo + (size_t)(t0 + r) * D + 4 * lane + 256 * j) = x[r][j];
                    else { v2u o; o.x = pk2(x[r][j][0], x[r][j][1]); o.y = pk2(x[r][j][2], x[r][j][3]); *(GAS v2u*)(xbo + (size_t)(t0 + r) * D + 4 * lane + 256 * j) = o; } } }
            if (l + 1 < DEPTH) {
#pragma unroll
                for (int r = 0; r < R3N; ++r) ln_stats(x[r], mean[r], rstd[r]);
#pragma unroll
                for (int j = 0; j < 4; ++j) { const f32x4 s1 = PV[3 * 256 + lane + 64 * j], s0 = PV[4 * 256 + lane + 64 * j];
#pragma unroll
                    for (int r = 0; r < R3N; ++r) { const f32x4 u = (x[r][j] - mean[r]) * rstd[r] * (1.0f + s1) + s0; v2u o; o.x = pk2(u[0], u[1]); o.y = pk2(u[2], u[3]); *(GAS v2u*)(U + (size_t)(t0 + r) * D + 4 * lane + 256 * j) = o; } } }
        }
    }
}

__global__ void __launch_bounds__(512, 2) fwd(Args a) {
    extern __shared__ __attribute__((aligned(16))) unsigned char lds_raw[];
    LAS unsigned char* lds = (LAS unsigned char*)lds_raw;
    volatile LAS unsigned* MISC = (volatile LAS unsigned*)(lds + MISC_OFF);
    const int tid = threadIdx.x, lane = tid & 63, wave = __builtin_amdgcn_readfirstlane(tid >> 6), G = gridDim.x, wg = blockIdx.x;
    const int wave_s = wave;
    const int gw = wg * 8 + wave, NGW = G * 8;
    unsigned* ctl = (unsigned*)(a.ws + WS_CTL);
    for (int u = tid; u < (LDS_BYTES - MISC_OFF) / 4; u += 512) MISC[u] = 0u;
    __syncthreads();
#if MK_ONE_LAUNCH
    XcdBarrier bar = xcd_barrier_post(ctl + CW_BAR, MISC);
#define GRID_BAR() xcd_barrier(bar)
#else
#define GRID_BAR() do { } while (0)
#endif
    const int lo = a.ph_lo, hi = a.ph_hi;
#define IN(k) (lo <= (k) && (k) < hi)
static_assert(CVT_TICKETS_L * 3 == BATCH * NH * 6, "conversion tickets interleave 1 : 3 with the attention tickets");
static_assert(pg8::BIAS_LDS_OFF == MISC_OFF + 4096 && pg8::BIAS_LDS_OFF + 2048 <= LDS_BYTES, "bias staging area inside the LDS control region");
#define BOTH(k) (IN(k) && IN((k) + 1))
#ifndef ONLY_PHASE
#define ONLY_PHASE -1
#endif
#define PH_ON(k) (ONLY_PHASE < 0 || ONLY_PHASE == (k))
    if (PH_ON(100) && IN(0)) { p0_mods(a, lds, wg, G, wave, lane, tid);
        p0_convert(a, lds, gw, NGW, wave, lane); if (BOTH(0)) GRID_BAR(); }
    if (PH_ON(101) && IN(1)) { p_r0(a, gw, NGW, lane); if (BOTH(1)) GRID_BAR(); }
#pragma unroll 1
    for (int l = 0; l < DEPTH; ++l) {
        const int g0 = 2 + NPH_LAYER * l;
#define OPAQUE_TID() unsigned tid_z = 0u; asm volatile("" : "+v"(tid_z)); int tid = wave_s * 64 + (int)__builtin_amdgcn_mbcnt_hi(~0u, __builtin_amdgcn_mbcnt_lo(~0u, tid_z)); asm volatile("" : "+v"(tid)); const int lane = tid & 63; const int wave = __builtin_amdgcn_readfirstlane(tid >> 6); const int gw = wg * 8 + wave; (void)lane; (void)gw
        if (PH_ON(0) && IN(g0 + 0)) { OPAQUE_TID();
            pg8::Gemm g{(const bf16*)(a.ws + WS_U), (const bf16*)(a.ws + WS_WIN) + (size_t)l * NIN * D, D, 0, nullptr};
            pg8::TileOrder S; S.init(T / 256, NIN / 256, G, wg, nullptr, PROJ_WGM);
            pg8::EpiBf16 E{(bf16*)(a.ws + WS_QKV), NIN, nullptr, 0, 1.0f};
            pg8::gemm_phase<pg8::EpiBf16, pg8::TileOrder, true, true>(lds, g, S, E, tid);
            if (BOTH(g0 + 0)) GRID_BAR();
        }
        if (PH_ON(1) && IN(g0 + 1)) { OPAQUE_TID();
            unsigned* qctr = ctl + CW_QCTR + 64 * l;
            constexpr int NLRU = 128, NATT = BATCH * NH * 6;
            constexpr int ncvt = CVT_TICKETS_L, NTK = NLRU + ncvt + NATT;
            for (;;) {
                if (tid == 0) MISC[MW_TICKET] = __hip_atomic_fetch_add(qctr, 1u, RLX_AGENT);
                __syncthreads();
                const int tk = (int)MISC[MW_TICKET];
                __syncthreads();
                if (tk >= NTK) break;
                unsigned tz = 0u; asm volatile("" : "+v"(tz)); const int lane_t = (int)__builtin_amdgcn_mbcnt_hi(~0u, __builtin_amdgcn_mbcnt_lo(~0u, tz)), tid_t = wave_s * 64 + lane_t; int wave_t = wave_s; asm volatile("" : "+s"(wave_t));
                if (tk < NLRU) lru::unit(lds, a, l, tk, wave_t, lane_t, tid_t);
                else { const int tp = tk - NLRU, g4 = tp >> 2;
                    if ((tp & 3) == 0) cvt_ticket(a, lds, l, g4, wave_t, lane_t); else att::ticket(lds, a, tp - g4 - 1, wave_t, lane_t); }
            }
            if (BOTH(g0 + 1)) GRID_BAR();
        }
        if (PH_ON(2) && IN(g0 + 2)) { OPAQUE_TID(); p_merge(a, l, gw, NGW, lane); if (BOTH(g0 + 2)) GRID_BAR(); }
        if (PH_ON(3) && IN(g0 + 3)) { OPAQUE_TID();
            pg8::Gemm g{(const bf16*)(a.ws + WS_U), (const bf16*)(a.ws + WS_WOUT) + (size_t)l * D * D, D, 0, nullptr};
            pg8::TileOrder S; S.init(T / 256, D / 256, G, wg, nullptr, PROJ_WGM);
            pg8::EpiBf16 E{(bf16*)(a.ws + WS_MIX), D, nullptr, 0, 1.0f};
            pg8::gemm_phase<pg8::EpiBf16, pg8::TileOrder, true, true>(lds, g, S, E, tid);
            if (BOTH(g0 + 3)) GRID_BAR();
        }
        if (PH_ON(4) && IN(g0 + 4)) { OPAQUE_TID(); p_r2(a, lds, MISC, l, wg, G, wave, lane, tid); if (BOTH(g0 + 4)) GRID_BAR(); }
        if (PH_ON(5) && IN(g0 + 5)) { OPAQUE_TID(); p_dispatch(a, lds, MISC, l, wg, G, wave, lane, tid); if (BOTH(g0 + 5)) GRID_BAR(); }
        if (PH_ON(6) && IN(g0 + 6)) { OPAQUE_TID();
            const int ntiles = build_tiles(a, MISC, l, tid);
            pg8::Gemm g{(const bf16*)(a.ws + WS_U8), (const bf16*)(a.ws + WS_W1 + (size_t)l * NE * 2 * DFF * D), D / 2, (size_t)2 * DFF * D, (const int*)(a.ws + WS_ROWMAP)};
            pg8::TileOrder S; S.init(ntiles, 8, G, wg, (const LAS unsigned short*)(MISC + MW_TILEE), MOE_WGM);
            pg8::EpiSwiglu8 E{a.ws + WS_ACT, a.in[I_B1] + (size_t)l * NE * 2 * DFF, 1.0f / (F8_SA1 * F8_SW), F8_SA2};
            pg8::gemm_phase<pg8::EpiSwiglu8, pg8::TileOrder, true, true, true, true>(lds, g, S, E, tid);
            if (BOTH(g0 + 6)) GRID_BAR();
        }
        if (PH_ON(7) && IN(g0 + 7)) { OPAQUE_TID();
            const int ntiles = build_tiles(a, MISC, l, tid);
            pg8::Gemm g{(const bf16*)(a.ws + WS_ACT), (const bf16*)(a.ws + WS_W2 + (size_t)l * NE * D * DFF), DFF / 2, (size_t)D * DFF, nullptr};
            pg8::TileOrder S; S.init(ntiles, 4, G, wg, (const LAS unsigned short*)(MISC + MW_TILEE), MOE_WGM);
            pg8::EpiFp8 E{a.ws + WS_XG, D, a.in[I_B2] + (size_t)l * NE * D, D, 1.0f / (F8_SA2 * F8_SW), F8_SZ};
            pg8::gemm_phase<pg8::EpiFp8, pg8::TileOrder, true, true, true>(lds, g, S, E, tid);
            if (BOTH(g0 + 7)) GRID_BAR();
        }
        if (PH_ON(8) && IN(g0 + 8)) { OPAQUE_TID(); p_r3(a, lds, l, wg, G, wave, lane, tid); if (BOTH(g0 + 8)) GRID_BAR(); }
    }
}

extern "C" void kernel_launch(void* const* d_in, const int* in_sizes, int n_in, void* d_out, int out_size, void* d_ws, size_t ws_size, hipStream_t stream) {
    static int grid = 0;
    if (grid == 0) {
        if (n_in != 25 || out_size != T * D || ws_size < WS_END) { fprintf(stderr, "kernel_launch: unexpected shapes (n_in %d out %d ws %zu)\n", n_in, out_size, ws_size); grid = -1; return; }
        int dev = 0, cus = 0, per_cu = 0;
        if (hipGetDevice(&dev) != hipSuccess || hipDeviceGetAttribute(&cus, hipDeviceAttributeMultiprocessorCount, dev) != hipSuccess) { grid = -1; return; }
        if (hipFuncSetAttribute((const void*)fwd, hipFuncAttributeMaxDynamicSharedMemorySize, LDS_BYTES) != hipSuccess) { fprintf(stderr, "kernel_launch: hipFuncSetAttribute failed\n"); grid = -1; return; }
        if (hipOccupancyMaxActiveBlocksPerMultiprocessor(&per_cu, (const void*)fwd, 512, LDS_BYTES) != hipSuccess || per_cu < 1) fprintf(stderr, "kernel_launch: occupancy query reports %d\n", per_cu);
        (void)hipGetLastError();
        grid = cus;
    }
    if (grid < 0) return;
    (void)hipMemsetAsync((char*)d_ws + WS_CTL, 0, CTL_ZERO_BYTES, stream);
    Args a{};
    for (int i = 0; i < 25; ++i) a.in[i] = (const float*)d_in[i];
    a.out = (float*)d_out; a.ws = (unsigned char*)d_ws;
#if MK_ONE_LAUNCH
    a.ph_lo = 0; a.ph_hi = NPH;
    hipLaunchKernelGGL(fwd, dim3(grid), dim3(512), LDS_BYTES, stream, a);
#else
    for (int p = 0; p < NPH; ++p) { a.ph_lo = p; a.ph_hi = p + 1; hipLaunchKernelGGL(fwd, dim3(grid), dim3(512), LDS_BYTES, stream, a); }
#endif
}
```

```cpp
#include <hip/hip_runtime.h>
#include <cstdio>
#include <cstdint>
namespace pg8 {
#define PG8_LAS __attribute__((address_space(3)))
typedef unsigned short bf16_t;
typedef short bf16x8 __attribute__((ext_vector_type(8)));
typedef float f32x4 __attribute__((ext_vector_type(4)));
typedef float f32x2 __attribute__((ext_vector_type(2)));
typedef unsigned u32x4 __attribute__((ext_vector_type(4)));
typedef unsigned u32x2 __attribute__((ext_vector_type(2)));
typedef int v8i32 __attribute__((ext_vector_type(8)));
constexpr int BM = 256, BK = 64, HALF = 128, HTB = HALF * BK * 2, STAGE_BYTES = 8 * HTB, NXCD = 8, WGM = 8;
constexpr int ROWMAP_LDS_OFF = STAGE_BYTES + 1024 + 4096 + 2048;
constexpr int BIAS_LDS_OFF = STAGE_BYTES + 1024 + 4096;
__host__ __device__ __forceinline__ int lds_byte(int r, int c) { const int st = (r >> 4) * 2 + (c >> 5), rr = r & 15, cc = c & 31, ob = rr * 64 + cc * 2; return st * 1024 + (ob ^ (((ob >> 9) & 1) << 5)); }
__host__ __device__ __forceinline__ void stage_rc(int b, int& R, int& C) { const int st = b / 1024, sb = b % 1024, swz = sb ^ (((sb >> 9) & 1) << 5); R = (st >> 1) * 16 + swz / 64; C = (st & 1) * 32 + (swz % 64) / 2; }
__host__ __device__ __forceinline__ int perm32(int rho) { const int n = rho >> 4, i = rho & 15; return 8 * (i >> 2) + 4 * n + (i & 3); }
struct Unit { int pm, pn, e, par; };
struct Gemm { const bf16_t* A; const bf16_t* Bt; int K; size_t bstride; const int* rowmap; };
struct TileOrder {
    int nM, nN, nwg, G, c, wgm; const PG8_LAS unsigned short* tile_e;
    __device__ void init(int nM_, int nN_, int G_, int c_, const PG8_LAS unsigned short* te, int wgm_ = WGM) { nM = nM_; nN = nN_; nwg = nM * nN; G = G_; c = c_; tile_e = te; wgm = wgm_; }
    __device__ bool next(int i, Unit& u) const {
        const long L = (long)i * G + c; if (L >= nwg) return false;
        int wgid = (int)L; { const int q = nwg / NXCD, r = nwg % NXCD, xcd = wgid % NXCD, off = wgid / NXCD; wgid = (xcd < r ? xcd * (q + 1) : r * (q + 1) + (xcd - r) * q) + off; }
        const int nig = wgm * nN, gid = wgid / nig, fm = gid * wgm, gsz = (nM - fm) < wgm ? (nM - fm) : wgm;
        u.pm = fm + ((wgid % nig) % gsz); u.pn = (wgid % nig) / gsz; u.e = tile_e ? (int)tile_e[u.pm] : 0; return true;
    }
    __device__ __forceinline__ void a_ready(const Unit&) const {}
    __device__ __forceinline__ void done(const Unit&) const {}
};
__device__ __forceinline__ unsigned cvt_pk_bf16(float lo, float hi) { typedef __bf16 bf2_t __attribute__((ext_vector_type(2))); const f32x2 v = {lo, hi}; return __builtin_bit_cast(unsigned, __builtin_convertvector(v, bf2_t)); }
__device__ __forceinline__ unsigned pk4_fp8(float a, float b, float c, float d) { int w = 0; w = __builtin_amdgcn_cvt_pk_fp8_f32(a, b, w, false); w = __builtin_amdgcn_cvt_pk_fp8_f32(c, d, w, true); return (unsigned)w; }
struct EpiBf16 {
    static constexpr bool PERM = true, AFTER_DRAIN = false; static constexpr int NST = 16;
    bf16_t* O; int ldc; const float* bias; int bias_stride; float scale;
    __device__ __forceinline__ void prefetch(const Unit&, int, int, PG8_LAS unsigned char*) const {}
    __device__ __forceinline__ void operator()(const f32x4 (&acc)[2][2][4][2], const Unit& u, int wr, int wc, int fr, int fq, PG8_LAS unsigned char* lds) const {
        int row0 = u.pm * BM + wr * 64 + fr; int col0 = u.pn * BM + wc * 32 + 8 * fq;
        asm volatile("" : "+v"(row0), "+v"(col0));
        f32x4 bv[2][2];
#pragma unroll
        for (int bj = 0; bj < 2; ++bj)
#pragma unroll
            for (int n = 0; n < 2; ++n) bv[bj][n] = bias ? *(const f32x4*)(bias + (size_t)u.e * bias_stride + col0 + bj * HALF + 4 * n) : (f32x4){0.f, 0.f, 0.f, 0.f};
#pragma unroll
        for (int ai = 0; ai < 2; ++ai)
#pragma unroll
            for (int m = 0; m < 4; ++m) { bf16_t* rowp = O + (size_t)(row0 + ai * HALF + m * 16) * ldc + col0;
#pragma unroll
                for (int bj = 0; bj < 2; ++bj) { const f32x4 v0 = acc[ai][bj][m][0] * scale + bv[bj][0], v1 = acc[ai][bj][m][1] * scale + bv[bj][1];
                    u32x4 w; w.x = cvt_pk_bf16(v0[0], v0[1]); w.y = cvt_pk_bf16(v0[2], v0[3]); w.z = cvt_pk_bf16(v1[0], v1[1]); w.w = cvt_pk_bf16(v1[2], v1[3]);
                    *(u32x4*)(rowp + bj * HALF) = w; } }
    }
};
struct EpiFp8 {
    static constexpr bool PERM = true, AFTER_DRAIN = false; static constexpr int NST = 8;
    unsigned char* O; int ldc; const float* bias; int bias_stride; float scale, out_scale;
    __device__ __forceinline__ void prefetch(const Unit& u, int wid, int lane, PG8_LAS unsigned char* lds) const {
        if (wid == 0) __builtin_amdgcn_global_load_lds((const unsigned*)(bias + (size_t)u.e * bias_stride + u.pn * BM + 4 * lane), (PG8_LAS unsigned*)(lds + BIAS_LDS_OFF + u.par * 1024), 16, 0, 0); }
    __device__ __forceinline__ void operator()(const f32x4 (&acc)[2][2][4][2], const Unit& u, int wr, int wc, int fr, int fq, PG8_LAS unsigned char* lds) const {
        int row0 = u.pm * BM + wr * 64 + fr; int col0 = u.pn * BM + wc * 32 + 8 * fq;
        asm volatile("" : "+v"(row0), "+v"(col0));
        f32x4 bv[2][2];
#pragma unroll
        for (int bj = 0; bj < 2; ++bj)
#pragma unroll
            for (int n = 0; n < 2; ++n) bv[bj][n] = *(const PG8_LAS f32x4*)(lds + BIAS_LDS_OFF + u.par * 1024 + (wc * 32 + 8 * fq + bj * HALF + 4 * n) * 4) * out_scale;
        const float sc = scale * out_scale;
        const int odd = fq & 1; unsigned char* obase = O + (size_t)(row0 + odd * 16) * ldc + (col0 - 8 * odd);
#pragma unroll
        for (int ai = 0; ai < 2; ++ai)
#pragma unroll
            for (int mp = 0; mp < 2; ++mp) { unsigned char* rowp = obase + (size_t)(ai * HALF + mp * 32) * ldc;
#pragma unroll
                for (int bj = 0; bj < 2; ++bj) { u32x2 w[2];
#pragma unroll
                    for (int q = 0; q < 2; ++q) { const int m = 2 * mp + q; const f32x4 v0 = acc[ai][bj][m][0] * sc + bv[bj][0], v1 = acc[ai][bj][m][1] * sc + bv[bj][1];
                        w[q].x = pk4_fp8(v0[0], v0[1], v0[2], v0[3]); w[q].y = pk4_fp8(v1[0], v1[1], v1[2], v1[3]); }
                    const auto sx = __builtin_amdgcn_permlane16_swap(w[0].x, w[1].x, false, false), sy = __builtin_amdgcn_permlane16_swap(w[0].y, w[1].y, false, false);
                    u32x4 o; o.x = sx[0]; o.y = sy[0]; o.z = sx[1]; o.w = sy[1];
                    *(u32x4*)(rowp + bj * HALF) = o; } }
    }
};
__device__ __forceinline__ float swiglu1(float g, float u) {
    g = fminf(g, 7.0f); u = fminf(fmaxf(u, -7.0f), 7.0f);
    const float sg = __builtin_amdgcn_rcpf(1.0f + __builtin_amdgcn_exp2f(g * (-1.702f * 1.44269504f)));
    return g * sg * (u + 1.0f);
}
__device__ __forceinline__ f32x2 swiglu2s(f32x2 g, f32x2 u, float os) {
    g[0] = fminf(g[0], 7.0f); g[1] = fminf(g[1], 7.0f); u[0] = fminf(fmaxf(u[0], -7.0f), 7.0f); u[1] = fminf(fmaxf(u[1], -7.0f), 7.0f);
    const f32x2 x = g * (f32x2){-1.702f * 1.44269504f, -1.702f * 1.44269504f};
    f32x2 d; d[0] = __builtin_amdgcn_exp2f(x[0]); d[1] = __builtin_amdgcn_exp2f(x[1]); d = d + (f32x2){1.0f, 1.0f};
    f32x2 r; r[0] = __builtin_amdgcn_rcpf(d[0]); r[1] = __builtin_amdgcn_rcpf(d[1]);
    const f32x2 osv = {os, os};
    return (g * r) * (u * osv + osv);
}
struct EpiSwiglu8 {
    static constexpr bool PERM = true, AFTER_DRAIN = false; static constexpr int NST = 4;
    unsigned char* O; const float* b1; float in_scale, out_scale;
    __device__ __forceinline__ void prefetch(const Unit& u, int wid, int lane, PG8_LAS unsigned char* lds) const {
        if (wid == 0) __builtin_amdgcn_global_load_lds((const unsigned*)(b1 + (size_t)u.e * 2048 + (lane < 32 ? u.pn * HALF + 4 * lane : 1024 + u.pn * HALF + 4 * (lane - 32))), (PG8_LAS unsigned*)(lds + BIAS_LDS_OFF + u.par * 1024), 16, 0, 0); }
    __device__ __forceinline__ void operator()(const f32x4 (&acc)[2][2][4][2], const Unit& u, int wr, int wc, int fr, int fq, PG8_LAS unsigned char* lds) const {
        int row0 = u.pm * BM + wr * 64 + fr; int col0 = u.pn * HALF + wc * 32 + 8 * fq;
        asm volatile("" : "+v"(row0), "+v"(col0));
        f32x4 bgv[2], buv[2];
#pragma unroll
        for (int n = 0; n < 2; ++n) { bgv[n] = *(const PG8_LAS f32x4*)(lds + BIAS_LDS_OFF + u.par * 1024 + (wc * 32 + 8 * fq + 4 * n) * 4); buv[n] = *(const PG8_LAS f32x4*)(lds + BIAS_LDS_OFF + u.par * 1024 + (HALF + wc * 32 + 8 * fq + 4 * n) * 4); }
        const int odd = fq & 1; unsigned char* obase = O + (size_t)(row0 + odd * 16) * 1024 + (col0 - 8 * odd);
#pragma unroll
        for (int ai = 0; ai < 2; ++ai)
#pragma unroll
            for (int mp = 0; mp < 2; ++mp) { unsigned char* rowp = obase + (size_t)(ai * HALF + mp * 32) * 1024; u32x2 w[2];
#pragma unroll
                for (int q = 0; q < 2; ++q) { const int m = 2 * mp + q;
                    const f32x4 g0 = acc[ai][0][m][0] * in_scale + bgv[0], g1 = acc[ai][0][m][1] * in_scale + bgv[1], u0 = acc[ai][1][m][0] * in_scale + buv[0], u1 = acc[ai][1][m][1] * in_scale + buv[1];
                    const f32x2 a0 = swiglu2s((f32x2){g0[0], g0[1]}, (f32x2){u0[0], u0[1]}, out_scale), a1 = swiglu2s((f32x2){g0[2], g0[3]}, (f32x2){u0[2], u0[3]}, out_scale);
                    const f32x2 a2 = swiglu2s((f32x2){g1[0], g1[1]}, (f32x2){u1[0], u1[1]}, out_scale), a3 = swiglu2s((f32x2){g1[2], g1[3]}, (f32x2){u1[2], u1[3]}, out_scale);
                    w[q].x = pk4_fp8(a0[0], a0[1], a1[0], a1[1]); w[q].y = pk4_fp8(a2[0], a2[1], a3[0], a3[1]); }
                const auto sx = __builtin_amdgcn_permlane16_swap(w[0].x, w[1].x, false, false), sy = __builtin_amdgcn_permlane16_swap(w[0].y, w[1].y, false, false);
                u32x4 o; o.x = sx[0]; o.y = sy[0]; o.z = sx[1]; o.w = sy[1];
                *(u32x4*)rowp = o; }
    }
};
struct EpiSwiglu {
    static constexpr bool PERM = true, AFTER_DRAIN = false; static constexpr int NST = 8;
    bf16_t* O; const float* b1;
    __device__ __forceinline__ void prefetch(const Unit&, int, int, PG8_LAS unsigned char*) const {}
    __device__ __forceinline__ void operator()(const f32x4 (&acc)[2][2][4][2], const Unit& u, int wr, int wc, int fr, int fq, PG8_LAS unsigned char* lds) const {
        int row0 = u.pm * BM + wr * 64 + fr; int col0 = u.pn * HALF + wc * 32 + 8 * fq;
        asm volatile("" : "+v"(row0), "+v"(col0));
        const float* bg = b1 + (size_t)u.e * 2048 + col0;
        f32x4 bgv[2], buv[2];
#pragma unroll
        for (int n = 0; n < 2; ++n) { bgv[n] = *(const f32x4*)(bg + 4 * n); buv[n] = *(const f32x4*)(bg + 1024 + 4 * n); }
#pragma unroll
        for (int ai = 0; ai < 2; ++ai)
#pragma unroll
            for (int m = 0; m < 4; ++m) { bf16_t* rowp = O + (size_t)(row0 + ai * HALF + m * 16) * 1024 + col0;
                const f32x4 g0 = acc[ai][0][m][0] + bgv[0], g1 = acc[ai][0][m][1] + bgv[1], u0 = acc[ai][1][m][0] + buv[0], u1 = acc[ai][1][m][1] + buv[1];
                u32x4 w; w.x = cvt_pk_bf16(swiglu1(g0[0], u0[0]), swiglu1(g0[1], u0[1])); w.y = cvt_pk_bf16(swiglu1(g0[2], u0[2]), swiglu1(g0[3], u0[3]));
                w.z = cvt_pk_bf16(swiglu1(g1[0], u1[0]), swiglu1(g1[1], u1[1])); w.w = cvt_pk_bf16(swiglu1(g1[2], u1[2]), swiglu1(g1[3], u1[3]));
                *(u32x4*)rowp = w; }
    }
};
template <class Epi, class Sched, bool ALIGN_EPI = false, bool SP2 = false, bool F8 = false, bool GATHER = false>
__device__ __forceinline__ void gemm_phase(PG8_LAS unsigned char* lds, const Gemm g, const Sched& S, const Epi& E, const int tid_in) {
    const int tid = tid_in, wid = __builtin_amdgcn_readfirstlane(tid >> 6), lane = tid & 63, wr = wid >> 2, wc = wid & 3, fr = lane & 15, fq = lane >> 4;
    const int K = g.K, nt = K / BK;
    unsigned voffA[2], voffB[2];
#pragma unroll
    for (int i = 0; i < 2; ++i) { int R, C; stage_rc(tid * 16 + i * 8192, R, C); const int Rb = Epi::PERM ? ((R & ~31) + perm32(R & 31)) : R;
        voffA[i] = (unsigned)(R * K + C) * 2u; voffB[i] = (unsigned)(Rb * K + C) * 2u; }
    unsigned ga_cur[2][2], ga_nxt[2][2];
#define PG8_LOADGA(dst, unit) do { _Pragma("unroll") for (int _i = 0; _i < 2; ++_i) { int _R, _C; stage_rc(tid * 16 + _i * 8192, _R, _C); _Pragma("unroll") for (int _h = 0; _h < 2; ++_h) \
        dst[_h][_i] = (unsigned)g.rowmap[(unit).pm * BM + _R + HALF * _h] * (unsigned)(K * 2) + (unsigned)_C * 2u; } } while (0)
#define PG8_LOADGA_LDS(dst) do { _Pragma("unroll") for (int _i = 0; _i < 2; ++_i) { int _R, _C; stage_rc(tid * 16 + _i * 8192, _R, _C); _Pragma("unroll") for (int _h = 0; _h < 2; ++_h) \
        dst[_h][_i] = (unsigned)((const PG8_LAS int*)(lds + ROWMAP_LDS_OFF))[_R + HALF * _h] * (unsigned)(K * 2) + (unsigned)_C * 2u; } } while (0)
    const size_t kstep = (size_t)(BK * 2);
    const size_t hstep = (size_t)HALF * K * 2;
    const size_t tstep = 2 * hstep;
    const unsigned ldsw = (unsigned)wid * 1024u;
    const int aoff = lds_byte(wr * 64 + fr, fq * 8), boff = lds_byte(wc * 32 + fr, fq * 8);
#define PG8_SA(b, h) (((b) * 2 + (h)) * HTB)
#define PG8_SB(b, h) ((4 + (b) * 2 + (h)) * HTB)
#define PG8_STAGE(bufoff, gbase, voff) do { _Pragma("unroll") for (int _i = 0; _i < 2; ++_i) \
        __builtin_amdgcn_global_load_lds((const unsigned*)((const char*)(gbase) + (voff)[_i]), (PG8_LAS unsigned*)(lds + (bufoff) + ldsw + _i * 8192), 16, 0, 0); } while (0)
#define PG8_LDA(dst, b, h) do { _Pragma("unroll") for (int m = 0; m < 4; ++m) _Pragma("unroll") for (int k = 0; k < 2; ++k) dst[m][k] = *(const PG8_LAS bf16x8*)(lds + PG8_SA(b, h) + aoff + m * 2048 + k * 1024); } while (0)
#define PG8_LDB(dst, b, h) do { _Pragma("unroll") for (int n = 0; n < 2; ++n) _Pragma("unroll") for (int k = 0; k < 2; ++k) dst[n][k] = *(const PG8_LAS bf16x8*)(lds + PG8_SB(b, h) + boff + n * 2048 + k * 1024); } while (0)
#define PG8_CAT8(x, y) __builtin_bit_cast(v8i32, __builtin_shufflevector((x), (y), 0, 1, 2, 3, 4, 5, 6, 7, 8, 9, 10, 11, 12, 13, 14, 15))
#define PG8_MMA(ai, bj, At, Bt) do { __builtin_amdgcn_s_setprio(1); \
        if constexpr (F8) { _Pragma("unroll") for (int m = 0; m < 4; ++m) _Pragma("unroll") for (int n = 0; n < 2; ++n) \
            asm volatile("v_mfma_scale_f32_16x16x128_f8f6f4 %0, %1, %2, %0, %3, %3 op_sel_hi:[0,0,0]" : "+v"(acc[ai][bj][m][n]) : "v"(PG8_CAT8(Bt[n][0], Bt[n][1])), "v"(PG8_CAT8(At[m][0], At[m][1])), "v"(f8_scale)); } \
        else { _Pragma("unroll") for (int m = 0; m < 4; ++m) _Pragma("unroll") for (int n = 0; n < 2; ++n) _Pragma("unroll") for (int k = 0; k < 2; ++k) \
            acc[ai][bj][m][n] = __builtin_amdgcn_mfma_f32_16x16x32_bf16(Bt[n][k], At[m][k], acc[ai][bj][m][n], 0, 0, 0); } \
        __builtin_amdgcn_s_setprio(0); } while (0)
#define PG8_WAIT_V(n) asm volatile("s_waitcnt vmcnt(" #n ")" ::: "memory")
#define PG8_WAIT_VR(relax) do { if (relax) asm volatile("s_waitcnt vmcnt(%0)" :: "n"(8 + Epi::NST) : "memory"); else asm volatile("s_waitcnt vmcnt(8)" ::: "memory"); } while (0)
#define PG8_WAIT_L(n) asm volatile("s_waitcnt lgkmcnt(" #n ")" ::: "memory")
#define PG8_BAR __builtin_amdgcn_s_barrier()
#define PG8_SCHED __builtin_amdgcn_sched_barrier(0)
    const int f8_scale = 0x7f7f7f7f; (void)f8_scale;
    Unit cur, nxt; int ui = 0;
    if (!S.next(0, cur)) return;
    f32x4 acc[2][2][4][2];
#pragma unroll
    for (int a = 0; a < 2; ++a)
#pragma unroll
        for (int b = 0; b < 2; ++b)
#pragma unroll
            for (int m = 0; m < 4; ++m)
#pragma unroll
                for (int n = 0; n < 2; ++n) acc[a][b][m][n] = (f32x4){0.f, 0.f, 0.f, 0.f};
    bf16x8 At[4][2], B0[2][2], B1[2][2];
    const char* cA = (const char*)g.A + (GATHER ? (size_t)0 : (size_t)cur.pm * tstep); const char* cB = (const char*)g.Bt + (size_t)cur.e * g.bstride + (size_t)cur.pn * tstep;
    const size_t hstepA = GATHER ? (size_t)0 : hstep;
    unsigned vA0c[2], vA1c[2];
    if constexpr (GATHER) { PG8_LOADGA(ga_cur, cur); vA0c[0] = ga_cur[0][0]; vA0c[1] = ga_cur[0][1]; vA1c[0] = ga_cur[1][0]; vA1c[1] = ga_cur[1][1]; }
    else { vA0c[0] = vA1c[0] = voffA[0]; vA0c[1] = vA1c[1] = voffA[1]; }
    cur.par = 0; E.prefetch(cur, wid, lane, lds);
    S.a_ready(cur);
    if constexpr (SP2) {
        PG8_STAGE(PG8_SB(0, 0), cB, voffB); PG8_STAGE(PG8_SB(0, 1), cB + hstep, voffB); PG8_STAGE(PG8_SA(0, 0), cA, vA0c); PG8_STAGE(PG8_SA(0, 1), cA + hstepA, vA1c);
        if (wr == 1) PG8_BAR;
        PG8_WAIT_V(2); PG8_BAR;
        PG8_STAGE(PG8_SB(1, 0), cB + kstep, voffB); PG8_STAGE(PG8_SA(1, 0), cA + kstep, vA0c); PG8_STAGE(PG8_SB(1, 1), cB + hstep + kstep, voffB);
        PG8_WAIT_V(6); PG8_BAR;
    } else {
        PG8_STAGE(PG8_SB(0, 0), cB, voffB); PG8_STAGE(PG8_SA(0, 0), cA, voffA); PG8_STAGE(PG8_SB(0, 1), cB + hstep, voffB); PG8_STAGE(PG8_SA(0, 1), cA + hstep, voffA);
        if (wr == 1) PG8_BAR;
        PG8_WAIT_V(4); PG8_BAR;
        PG8_STAGE(PG8_SB(1, 0), cB + kstep, voffB); PG8_STAGE(PG8_SA(1, 0), cA + kstep, voffA); PG8_STAGE(PG8_SB(1, 1), cB + hstep + kstep, voffB);
        PG8_WAIT_V(6); PG8_BAR;
    }
    for (;;) {
        const bool has_next = S.next(ui + 1, nxt); nxt.par = (ui + 1) & 1;
        if constexpr (GATHER) { if (has_next && wid == 0)
            __builtin_amdgcn_global_load_lds((const unsigned*)(g.rowmap + (size_t)nxt.pm * BM + 4 * lane), (PG8_LAS unsigned*)(lds + ROWMAP_LDS_OFF), 16, 0, 0); }
        const char* nA = (has_next && !GATHER) ? (const char*)g.A + (size_t)nxt.pm * tstep : cA;
        if constexpr (GATHER) { _Pragma("unroll") for (int _h = 0; _h < 2; ++_h) _Pragma("unroll") for (int _i = 0; _i < 2; ++_i) ga_nxt[_h][_i] = ga_cur[_h][_i]; } const char* nB = has_next ? (const char*)g.Bt + (size_t)nxt.e * g.bstride + (size_t)nxt.pn * tstep : cB;
#pragma unroll 1
        for (int t = 0; t < nt; t += 2) {
            const bool last = (t == nt - 2);
            unsigned vA0s[2], vA1s[2];
            if constexpr (GATHER) {
                if (has_next && t == nt - 4) PG8_LOADGA_LDS(ga_nxt);
                if (last) { vA0s[0] = ga_nxt[0][0]; vA0s[1] = ga_nxt[0][1]; vA1s[0] = ga_nxt[1][0]; vA1s[1] = ga_nxt[1][1]; }
                else { vA0s[0] = ga_cur[0][0]; vA0s[1] = ga_cur[0][1]; vA1s[0] = ga_cur[1][0]; vA1s[1] = ga_cur[1][1]; }
                vA1c[0] = ga_cur[1][0]; vA1c[1] = ga_cur[1][1];
            } else { vA0s[0] = vA1s[0] = voffA[0]; vA0s[1] = vA1s[1] = voffA[1]; }
            const char* a1 = cA + (size_t)(t + 1) * kstep;
            const char* a2 = last ? nA : cA + (size_t)(t + 2) * kstep; const char* b2 = last ? nB : cB + (size_t)(t + 2) * kstep;
            const char* a3 = a2 + kstep; const char* b3 = b2 + kstep;
            if (last && has_next) S.a_ready(nxt);
            const bool relax = SP2 && ALIGN_EPI && t == 0 && ui > 0;
            if constexpr (SP2) {
            PG8_LDB(B0, 0, 0); PG8_LDB(B1, 0, 1); PG8_SCHED; PG8_LDA(At, 0, 0); if (!relax) PG8_STAGE(PG8_SA(1, 1), a1 + hstepA, vA1c);
            PG8_WAIT_VR(relax); PG8_WAIT_L(0); PG8_BAR; PG8_MMA(0, 0, At, B0); PG8_MMA(0, 1, At, B1); PG8_BAR; PG8_SCHED;
            PG8_LDA(At, 0, 1); PG8_STAGE(PG8_SB(0, 0), b2, voffB); PG8_STAGE(PG8_SB(0, 1), b2 + hstep, voffB); PG8_STAGE(PG8_SA(0, 0), a2, vA0s);
            PG8_WAIT_VR(relax); PG8_WAIT_L(0); PG8_BAR; PG8_MMA(1, 0, At, B0); PG8_MMA(1, 1, At, B1); PG8_BAR; PG8_SCHED;
            PG8_LDB(B0, 1, 0); PG8_LDB(B1, 1, 1); PG8_SCHED; PG8_LDA(At, 1, 0); PG8_STAGE(PG8_SA(0, 1), a2 + hstepA, vA1s);
            PG8_WAIT_VR(relax); PG8_WAIT_L(0); PG8_BAR; PG8_MMA(0, 0, At, B0); PG8_MMA(0, 1, At, B1); PG8_BAR; PG8_SCHED;
            PG8_LDA(At, 1, 1); PG8_STAGE(PG8_SB(1, 0), b3, voffB); PG8_STAGE(PG8_SB(1, 1), b3 + hstep, voffB); PG8_STAGE(PG8_SA(1, 0), a3, vA0s);
            PG8_WAIT_V(8); PG8_WAIT_L(0); PG8_BAR; PG8_MMA(1, 0, At, B0); PG8_MMA(1, 1, At, B1); PG8_BAR; PG8_SCHED;
            } else {
            PG8_LDB(B0, 0, 0); PG8_SCHED; PG8_LDA(At, 0, 0); PG8_STAGE(PG8_SA(1, 1), a1 + hstep, voffA);
            PG8_WAIT_L(8); PG8_BAR; PG8_WAIT_L(0); PG8_MMA(0, 0, At, B0); PG8_BAR; PG8_SCHED;
            PG8_LDB(B1, 0, 1); PG8_STAGE(PG8_SB(0, 0), b2, voffB);
            PG8_BAR; PG8_WAIT_L(0); PG8_MMA(0, 1, At, B1); PG8_BAR;
            PG8_LDA(At, 0, 1); PG8_STAGE(PG8_SA(0, 0), a2, voffA);
            PG8_BAR; PG8_WAIT_L(0); PG8_MMA(1, 0, At, B0); PG8_BAR; PG8_SCHED;
            PG8_STAGE(PG8_SB(0, 1), b2 + hstep, voffB);
            PG8_WAIT_V(6); PG8_BAR; PG8_MMA(1, 1, At, B1); PG8_BAR;
            PG8_LDB(B0, 1, 0); PG8_SCHED; PG8_LDA(At, 1, 0); PG8_STAGE(PG8_SA(0, 1), a2 + hstep, voffA);
            PG8_WAIT_L(8); PG8_BAR; PG8_WAIT_L(0); PG8_MMA(0, 0, At, B0); PG8_BAR; PG8_SCHED;
            PG8_LDB(B1, 1, 1); PG8_STAGE(PG8_SB(1, 0), b3, voffB);
            PG8_BAR; PG8_WAIT_L(0); PG8_MMA(0, 1, At, B1); PG8_BAR;
            PG8_LDA(At, 1, 1); PG8_STAGE(PG8_SA(1, 0), a3, voffA);
            PG8_BAR; PG8_WAIT_L(0); PG8_MMA(1, 0, At, B0); PG8_BAR; PG8_SCHED;
            PG8_STAGE(PG8_SB(1, 1), b3 + hstep, voffB);
            PG8_WAIT_V(6); PG8_BAR; PG8_MMA(1, 1, At, B1); PG8_BAR;
            }
        }
        if constexpr (F8) asm volatile("s_nop 15\n\ts_nop 7" ::: "memory");
        if constexpr (ALIGN_EPI) { if (wr == 0) PG8_BAR; }
        if constexpr (SP2 && ALIGN_EPI) { if (has_next) {
            if constexpr (GATHER) { unsigned vn[2] = {ga_nxt[1][0], ga_nxt[1][1]}; PG8_STAGE(PG8_SA(1, 1), nA + kstep, vn); } else PG8_STAGE(PG8_SA(1, 1), nA + kstep + hstep, voffA); } }
        if constexpr (!Epi::AFTER_DRAIN) { E(acc, cur, wr, wc, fr, fq, lds); S.done(cur); }
        if (!has_next) break;
#pragma unroll
        for (int a = 0; a < 2; ++a)
#pragma unroll
            for (int b = 0; b < 2; ++b)
#pragma unroll
                for (int m = 0; m < 4; ++m)
#pragma unroll
                    for (int n = 0; n < 2; ++n) acc[a][b][m][n] = (f32x4){0.f, 0.f, 0.f, 0.f};
        cur = nxt; cA = nA; cB = nB; ++ui; E.prefetch(cur, wid, lane, lds);
        if constexpr (GATHER) { _Pragma("unroll") for (int _h = 0; _h < 2; ++_h) _Pragma("unroll") for (int _i = 0; _i < 2; ++_i) ga_cur[_h][_i] = ga_nxt[_h][_i]; vA0c[0] = ga_cur[0][0]; vA0c[1] = ga_cur[0][1]; }
        if constexpr (ALIGN_EPI) { if (wr == 1) PG8_BAR; }
    }
    PG8_WAIT_V(0);
    if constexpr (!ALIGN_EPI) { if (wr == 0) PG8_BAR; }
    PG8_BAR;
    if constexpr (Epi::AFTER_DRAIN) { E.fused(acc, cur, wr, wc, fr, fq, lds, wid, lane); S.done(cur); }
#undef PG8_SA
#undef PG8_SB
#undef PG8_STAGE
#undef PG8_LDA
#undef PG8_LDB
#undef PG8_MMA
#undef PG8_LOADGA
#undef PG8_LOADGA_LDS
#undef PG8_CAT8
#undef PG8_WAIT_V
#undef PG8_WAIT_VR
#undef PG8_WAIT_L
#undef PG8_BAR
#undef PG8_SCHED
}
}

#define GAS __attribute__((address_space(1)))
#define LAS __attribute__((address_space(3)))
typedef unsigned short bf16;
typedef unsigned v4u __attribute__((ext_vector_type(4)));
typedef unsigned v2u __attribute__((ext_vector_type(2)));
typedef float f32x4 __attribute__((ext_vector_type(4)));
typedef float f32x2 __attribute__((ext_vector_type(2)));
typedef short bf16x8 __attribute__((ext_vector_type(8)));
typedef short s16x4 __attribute__((ext_vector_type(4)));
typedef int v4i __attribute__((ext_vector_type(4)));
#define RLX_AGENT __ATOMIC_RELAXED, __HIP_MEMORY_SCOPE_AGENT
#define LDS_WAIT() asm volatile("s_waitcnt lgkmcnt(0)" ::: "memory")
#define VM_WAIT() asm volatile("s_waitcnt vmcnt(0)" ::: "memory")

#ifndef MK_ONE_LAUNCH
#define MK_ONE_LAUNCH 1
#endif

constexpr int BATCH = 32, SEQ = 2048, D = 1024, DEPTH = 4, T = BATCH * SEQ;
constexpr int NH = 12, HD = 64, AW = 768, LW = 256, NIN = 2816, NE = 32, TOPK = 4, DFF = 1024;
constexpr float ALPHA = 1.6817928305074292f, LN_EPS = 1e-5f, RMS_EPS = 1e-6f, LOG2E = 1.4426950408889634f;
constexpr int NSLOT_MAX = T * TOPK + NE * 256;
constexpr int NPH_LAYER = 9, NPH = 2 + DEPTH * NPH_LAYER;

constexpr size_t MiB = 1u << 20;
constexpr size_t WS_CTL = 0, CTL_ZERO_BYTES = 1 * MiB;
constexpr size_t WS_MODS = 1 * MiB, WS_TOPI = 4 * MiB, WS_TOPW = 5 * MiB, WS_SLOT = 6 * MiB, WS_WGB = 7 * MiB;
constexpr size_t WS_LSE = 8 * MiB, WS_WIN = 18 * MiB, WS_WOUT = 40 * MiB, WS_W1 = 48 * MiB, WS_W2 = 560 * MiB;
constexpr size_t WS_U = 816 * MiB, WS_QKV = 944 * MiB, WS_ATTP = 1296 * MiB, WS_LRU = 1584 * MiB, WS_MIX = 1616 * MiB;
constexpr size_t WS_X = 1744 * MiB, WS_X1 = 2000 * MiB, WS_XG = 2256 * MiB, WS_ACT = 2784 * MiB, WS_U8 = 3312 * MiB, WS_ROWMAP = 3376 * MiB  , WS_END = 3378 * MiB;
static_assert((size_t)NSLOT_MAX * D * 2 <= 528 * MiB, "slot buffers");
constexpr int CW_TMO = 0, CW_BAR = 4096, CW_QCTR = 8192, CW_ETOT = 16384;

constexpr int RING_BYTES = 131072, MISC_OFF = RING_BYTES + 1024, LDS_BYTES = RING_BYTES + 8192;
constexpr int MW_TICKET = 4, MW_HIST = 16, MW_WGB = 48, MW_EBASE = 80, MW_TILEE = 128, MW_ETOT = 700;

__device__ __forceinline__ unsigned f2bf(float f) { unsigned u = __builtin_bit_cast(unsigned, f); return (u + 0x7fffu + ((u >> 16) & 1u)) >> 16; }
__device__ __forceinline__ unsigned pk2(float lo, float hi) { typedef __bf16 bf2_t __attribute__((ext_vector_type(2))); const f32x2 v = {lo, hi}; return __builtin_bit_cast(unsigned, __builtin_convertvector(v, bf2_t)); }
__device__ __forceinline__ unsigned pk4_fp8(float a, float b, float c, float d) { int w = 0; w = __builtin_amdgcn_cvt_pk_fp8_f32(a, b, w, false); w = __builtin_amdgcn_cvt_pk_fp8_f32(c, d, w, true); return (unsigned)w; }
constexpr float F8_SW = 64.0f, F8_SA1 = 4.0f, F8_SA2 = 4.0f, F8_SZ = 32.0f;
typedef __bf16 bf16x2_t __attribute__((ext_vector_type(2)));
__device__ __forceinline__ unsigned pk2v(float lo, float hi) { const f32x2 v = {lo, hi}; const bf16x2_t b = __builtin_convertvector(v, bf16x2_t); return __builtin_bit_cast(unsigned, b); }
__device__ __forceinline__ float bf_lo(unsigned w) { return __builtin_bit_cast(float, w << 16); }
__device__ __forceinline__ float bf_hi(unsigned w) { return __builtin_bit_cast(float, w & 0xffff0000u); }
__device__ __forceinline__ float ex2(float x) { return __builtin_amdgcn_exp2f(x); }
__device__ __forceinline__ float rcp(float x) { return __builtin_amdgcn_rcpf(x); }
__device__ __forceinline__ float sigmoidf_(float x) { return rcp(1.0f + ex2(-LOG2E * x)); }

#define XB_TMO      128
#define XB_XCNT(j)  (256  + 64 * (j))
#define XB_XSUB(j)  (1280 + 64 * (j))
#define XB_XGEN(j)  (2304 + 64 * (j))
#define XB_TOP      3328
#define XB_TOPGEN   3392
#define XCD_BAR_WORDS 3456
#define XB_SPIN_CAP (1u << 18)

__device__ __forceinline__ unsigned xb_ld(unsigned* p)              { return __hip_atomic_load(p, __ATOMIC_RELAXED, __HIP_MEMORY_SCOPE_AGENT); }
__device__ __forceinline__ unsigned xb_add(unsigned* p, unsigned v) { return __hip_atomic_fetch_add(p, v, __ATOMIC_RELAXED, __HIP_MEMORY_SCOPE_AGENT); }
__device__ __forceinline__ unsigned xb_xcc_id() { return (unsigned)__builtin_amdgcn_s_getreg((3 << 11) | 20) & 0xFu; }
#define XB_SPIN(cond, bar) do { unsigned _sp = 0; while (cond) { __builtin_amdgcn_s_sleep(1); \
    if ((++_sp & 255u) == 0u) { if (xb_ld(&(bar)[XB_TMO])) break; if (_sp > XB_SPIN_CAP) { atomicAdd(&(bar)[XB_TMO], 1u); break; } } } } while (0)

struct XcdBarrier {
    unsigned* bar; unsigned x;
    volatile LAS unsigned* st;
};

__device__ __forceinline__ XcdBarrier xcd_barrier_post(unsigned* bar, volatile LAS unsigned* st) {
    XcdBarrier b; b.bar = bar; b.x = xb_xcc_id(); b.st = st;
    if (threadIdx.x == 0) (void)xb_add(&bar[XB_XCNT(b.x)], 1u);
    return b;
}
__device__ __forceinline__ void xcd_barrier_complete(unsigned* bar, unsigned x, unsigned& nloc, unsigned& nx) {
    const unsigned G = gridDim.x * gridDim.y * gridDim.z;
    unsigned sum, cnt, mine, sp = 0u;
    for (;;) {
        sum = 0u; cnt = 0u; mine = 0u;
#pragma unroll
        for (unsigned j = 0; j < 16; ++j) { const unsigned c = xb_ld(&bar[XB_XCNT(j)]); sum += c; cnt += (c > 0u) ? 1u : 0u; mine = (j == x) ? c : mine; }
        if (sum == G) break;
        __builtin_amdgcn_s_sleep(1);
        if ((++sp & 255u) == 0u) { if (xb_ld(&bar[XB_TMO])) break; if (sp > XB_SPIN_CAP) { atomicAdd(&bar[XB_TMO], 1u); break; } }
    }
    nloc = mine > 0u ? mine : 1u; nx = cnt > 0u ? cnt : 1u;
}

__device__ __forceinline__ void xcd_barrier(const XcdBarrier& b) {
    asm volatile("s_waitcnt vmcnt(0)" ::: "memory");
    __syncthreads();
    if (threadIdx.x == 0) {
        unsigned* bar = b.bar;
        __builtin_amdgcn_s_waitcnt(0);
        unsigned nloc = b.st[0], nx = b.st[1];
        if (nloc == 0u) { xcd_barrier_complete(bar, b.x, nloc, nx); b.st[0] = nloc; b.st[1] = nx; }
        const unsigned old = xb_add(&bar[XB_XSUB(b.x)], 1u);
        const unsigned gen = old / nloc;
        if (old + 1u == (gen + 1u) * nloc) {
            __builtin_amdgcn_fence(__ATOMIC_RELEASE, "agent");
            asm volatile("s_waitcnt vmcnt(0)" ::: "memory");
            const unsigned og = xb_add(&bar[XB_TOP], 1u);
            const unsigned tg = og / nx;
            if (og + 1u == (tg + 1u) * nx) xb_add(&bar[XB_TOPGEN], 1u);
            else XB_SPIN(xb_ld(&bar[XB_TOPGEN]) == tg, bar);
            __builtin_amdgcn_fence(__ATOMIC_ACQUIRE, "agent");
            xb_add(&bar[XB_XGEN(b.x)], 1u);
            asm volatile("s_waitcnt vmcnt(0)" ::: "memory");
        } else {
            XB_SPIN(xb_ld(&bar[XB_XGEN(b.x)]) == gen, bar);
            __builtin_amdgcn_fence(__ATOMIC_ACQUIRE, "agent");
            asm volatile("s_waitcnt vmcnt(0)" ::: "memory");
        }
    }
    __syncthreads();
}

template <int CTRL> __device__ __forceinline__ float dpp_f(float v) { return __builtin_bit_cast(float, __builtin_amdgcn_update_dpp(0, __builtin_bit_cast(int, v), CTRL, 0xF, 0xF, true)); }
__device__ __forceinline__ float rdlane(float v, int l) { return __builtin_bit_cast(float, __builtin_amdgcn_readlane(__builtin_bit_cast(int, v), l)); }
__device__ __forceinline__ float wave_sum(float v) {
    v += dpp_f<0xB1>(v); v += dpp_f<0x4E>(v); v += dpp_f<0x141>(v); v += dpp_f<0x140>(v);
    return (rdlane(v, 0) + rdlane(v, 16)) + (rdlane(v, 32) + rdlane(v, 48));
}
__device__ __forceinline__ float wave_max(float v) {
    v = fmaxf(v, dpp_f<0xB1>(v)); v = fmaxf(v, dpp_f<0x4E>(v)); v = fmaxf(v, dpp_f<0x141>(v)); v = fmaxf(v, dpp_f<0x140>(v));
    return fmaxf(fmaxf(rdlane(v, 0), rdlane(v, 16)), fmaxf(rdlane(v, 32), rdlane(v, 48)));
}

constexpr float ATT_C1 = 0.125f * 1.4426950408889634f;
struct Args { const float* in[25]; float* out; unsigned char* ws; int ph_lo, ph_hi; };
enum { I_X = 0, I_C, I_WCOND, I_BCOND, I_WIN, I_CONVW, I_CONVB, I_WA, I_BA, I_WX, I_BX, I_LAM, I_ANG, I_LNG, I_WOUT, I_LN1G, I_LN1B, I_RW, I_RB, I_W1, I_B1, I_W2, I_B2, I_LN2G, I_LN2B };

struct CvtItem { const float* src; unsigned char* dst; int N; int f8; float scale; };
__device__ __forceinline__ CvtItem cvt_decode(const Args& a, int it) {
    constexpr int KB = D / 32;
    constexpr int I_IN1 = KB * (NIN / 64), I_OUT1 = KB * (D / 64), I_W11 = KB * (2 * DFF / 64), I_W21 = KB * (D / 64);
    constexpr int N_IN = DEPTH * I_IN1, N_OUT = DEPTH * I_OUT1, N_W1 = DEPTH * NE * I_W11;
    CvtItem c; int r = it; c.scale = 1.0f;
    if (r < N_IN) { const int l = r / I_IN1, q = r % I_IN1, nb = q / KB, kb = q % KB; c.N = NIN; c.f8 = 0; c.scale = 64 * nb < AW ? ATT_C1 : 1.0f;
        c.src = a.in[I_WIN] + (size_t)l * D * NIN + (size_t)(32 * kb) * NIN + 64 * nb; c.dst = a.ws + WS_WIN + ((size_t)l * NIN * D + (size_t)(64 * nb) * D + 32 * kb) * 2; return c; }
    r -= N_IN;
    if (r < N_OUT) { const int l = r / I_OUT1, q = r % I_OUT1, nb = q / KB, kb = q % KB; c.N = D; c.f8 = 0;
        c.src = a.in[I_WOUT] + (size_t)l * D * D + (size_t)(32 * kb) * D + 64 * nb; c.dst = a.ws + WS_WOUT + ((size_t)l * D * D + (size_t)(64 * nb) * D + 32 * kb) * 2; return c; }
    r -= N_OUT;
    if (r < N_W1) { const int le = r / I_W11, q = r % I_W11, nb = q / KB, kb = q % KB, n0 = 64 * nb; c.N = 2 * DFF; c.f8 = 1;
        const int orow = n0 < DFF ? 256 * (n0 >> 7) + (n0 & 127) : 256 * ((n0 - DFF) >> 7) + 128 + ((n0 - DFF) & 127);
        c.src = a.in[I_W1] + (size_t)le * D * 2 * DFF + (size_t)(32 * kb) * 2 * DFF + n0; c.dst = a.ws + WS_W1 + (size_t)le * 2 * DFF * D + (size_t)orow * D + 32 * kb; return c; }
    r -= N_W1;
    { const int le = r / I_W21, q = r % I_W21, nb = q / KB, kb = q % KB; c.N = D; c.f8 = 1;
        c.src = a.in[I_W2] + (size_t)le * DFF * D + (size_t)(32 * kb) * D + 64 * nb; c.dst = a.ws + WS_W2 + (size_t)le * D * DFF + (size_t)(64 * nb) * DFF + 32 * kb; return c; }
}
__device__ __forceinline__ void cvt_load(const CvtItem& c, int lane, f32x4 (&v)[8]) {
#pragma unroll
    for (int i = 0; i < 8; ++i) { const int kk = 4 * i + (lane >> 4); v[i] = *(const GAS f32x4*)(c.src + (size_t)kk * c.N + 4 * (lane & 15)); }
}
__device__ __forceinline__ void cvt_store(const CvtItem& c, const f32x4 (&v)[8], LAS float* scr, int lane) {
#pragma unroll
    for (int i = 0; i < 8; ++i) { const int kk = 4 * i + (lane >> 4); LAS float* p = scr + kk * 65 + 4 * (lane & 15); p[0] = v[i][0]; p[1] = v[i][1]; p[2] = v[i][2]; p[3] = v[i][3]; }
    LDS_WAIT(); asm volatile("" ::: "memory");
    if (c.f8) {
#pragma unroll
        for (int j = 0; j < 2; ++j) { const int idx = lane + 64 * j, n = idx >> 1, cc = idx & 1; const LAS float* s = scr + (16 * cc) * 65 + n;
            v4u o; o.x = pk4_fp8(s[0 * 65] * F8_SW, s[1 * 65] * F8_SW, s[2 * 65] * F8_SW, s[3 * 65] * F8_SW); o.y = pk4_fp8(s[4 * 65] * F8_SW, s[5 * 65] * F8_SW, s[6 * 65] * F8_SW, s[7 * 65] * F8_SW);
            o.z = pk4_fp8(s[8 * 65] * F8_SW, s[9 * 65] * F8_SW, s[10 * 65] * F8_SW, s[11 * 65] * F8_SW); o.w = pk4_fp8(s[12 * 65] * F8_SW, s[13 * 65] * F8_SW, s[14 * 65] * F8_SW, s[15 * 65] * F8_SW);
            *(GAS v4u*)(c.dst + (size_t)n * D + 16 * cc) = o; }
    } else {
#pragma unroll
        for (int j = 0; j < 4; ++j) { const int idx = lane + 64 * j, n = idx >> 2, cc = idx & 3; const LAS float* s = scr + (8 * cc) * 65 + n;
            const float q = c.scale; v4u o; o.x = pk2(s[0 * 65] * q, s[1 * 65] * q); o.y = pk2(s[2 * 65] * q, s[3 * 65] * q); o.z = pk2(s[4 * 65] * q, s[5 * 65] * q); o.w = pk2(s[6 * 65] * q, s[7 * 65] * q);
            *(GAS v4u*)(c.dst + ((size_t)n * D + 8 * cc) * 2) = o; }
    }
    LDS_WAIT(); asm volatile("" ::: "memory");
}
constexpr int CVT_KB = D / 32, CVT_N_PROJ = DEPTH * CVT_KB * (NIN / 64) + DEPTH * CVT_KB * (D / 64), CVT_W1_L = NE * CVT_KB * (2 * DFF / 64), CVT_W2_L = NE * CVT_KB * (D / 64);
constexpr int CVT_N_W1 = DEPTH * CVT_W1_L, CVT_MOE_L = CVT_W1_L + CVT_W2_L, CVT_TICKET_ITEMS = 64, CVT_TICKETS_L = CVT_MOE_L / CVT_TICKET_ITEMS;
static_assert(CVT_MOE_L % CVT_TICKET_ITEMS == 0, "conversion tickets");
__device__ __forceinline__ int cvt_moe_item(int layer, int i) { return i < CVT_W1_L ? CVT_N_PROJ + layer * CVT_W1_L + i : CVT_N_PROJ + CVT_N_W1 + layer * CVT_W2_L + (i - CVT_W1_L); }
__device__ __forceinline__ int cvt_pro_item(int i) { return i < CVT_N_PROJ ? i : cvt_moe_item(0, i - CVT_N_PROJ); }
template <class Map> __device__ __forceinline__ void cvt_run(const Args& a, LAS float* scr, int count, int wk, int nw, int lane, Map map) {
    if (wk >= count) return;
    CvtItem cur = cvt_decode(a, map(wk)); f32x4 v[8]; cvt_load(cur, lane, v);
    for (int it = wk; it < count; it += nw) {
        const int nx = it + nw; CvtItem nxt = cur; f32x4 vn[8];
        if (nx < count) { nxt = cvt_decode(a, map(nx)); cvt_load(nxt, lane, vn); }
        cvt_store(cur, v, scr, lane);
        cur = nxt;
#pragma unroll
        for (int i = 0; i < 8; ++i) v[i] = vn[i];
    }
}
__device__ __forceinline__ void p0_convert(const Args& a, LAS unsigned char* lds, int gw, int NGW, int wave, int lane) {
    cvt_run(a, (LAS float*)(lds + wave * 8448), CVT_N_PROJ, gw, NGW, lane, [](int i) { return i; });
}
__device__ __forceinline__ void cvt_ticket(const Args& a, LAS unsigned char* lds, int layer, int tkc, int wave, int lane) {
    cvt_run(a, (LAS float*)(lds + wave * 8448), CVT_TICKET_ITEMS, wave, 8, lane, [=](int i) { return cvt_moe_item(layer, tkc * CVT_TICKET_ITEMS + i); });
}
__device__ __forceinline__ void p0_mods(const Args& a, LAS unsigned char* lds, int wg, int G, int wave, int lane, int tid) {
    LAS float* sc = (LAS float*)lds;
    for (int i = tid; i < BATCH * D; i += 512) { const float x = a.in[I_C][i]; sc[i] = x * sigmoidf_(x); }
    __syncthreads();
    float* mods = (float*)(a.ws + WS_MODS);
    constexpr int NCH = DEPTH * 6 * D / 64;
    for (int ch = wg; ch < NCH; ch += G) {
        const int l = ch / (6 * D / 64), col = (ch % (6 * D / 64)) * 64 + lane;
        const float* w = a.in[I_WCOND] + (size_t)l * D * 6 * D + col;
        float acc[4] = {0.f, 0.f, 0.f, 0.f};
        const LAS float* s0 = sc + (4 * wave) * D;
#pragma unroll 4
        for (int d0 = 0; d0 < D; d0 += 4) {
            float wv[4];
#pragma unroll
            for (int j = 0; j < 4; ++j) wv[j] = *(const GAS float*)(w + (size_t)(d0 + j) * 6 * D);
#pragma unroll
            for (int bb = 0; bb < 4; ++bb) { const f32x4 s = *(const LAS f32x4*)(s0 + bb * D + d0); acc[bb] += s[0] * wv[0] + s[1] * wv[1] + s[2] * wv[2] + s[3] * wv[3]; }
        }
        const float bc = a.in[I_BCOND][l * 6 * D + col];
#pragma unroll
        for (int bb = 0; bb < 4; ++bb) mods[((size_t)l * BATCH + 4 * wave + bb) * 6 * D + col] = acc[bb] + bc;
    }
    __syncthreads();
}

__device__ __forceinline__ void ln_stats(const f32x4 (&v)[4], float& mean, float& rstd) {
    float s = 0.f;
#pragma unroll
    for (int j = 0; j < 4; ++j) s += (v[j][0] + v[j][1]) + (v[j][2] + v[j][3]);
    mean = wave_sum(s) * (1.f / D); float q = 0.f;
#pragma unroll
    for (int j = 0; j < 4; ++j) { const f32x4 d = v[j] - mean; q += (d[0] * d[0] + d[1] * d[1]) + (d[2] * d[2] + d[3] * d[3]); }
    rstd = rsqrtf(wave_sum(q) * (1.f / D) + LN_EPS);
}
__device__ __forceinline__ void load_row4(const float* p, int lane, f32x4 (&v)[4]) {
#pragma unroll
    for (int j = 0; j < 4; ++j) v[j] = *(const GAS f32x4*)(p + 4 * lane + 256 * j);
}
__device__ __forceinline__ void load_row4_bf16(const bf16* p, int lane, f32x4 (&v)[4]) {
#pragma unroll
    for (int j = 0; j < 4; ++j) { const v2u w = *(const GAS v2u*)(p + 4 * lane + 256 * j); v[j] = (f32x4){bf_lo(w.x), bf_hi(w.x), bf_lo(w.y), bf_hi(w.y)}; }
}
__device__ __forceinline__ unsigned dpp_swap1(unsigned v) { return (unsigned)__builtin_amdgcn_update_dpp(0, (int)v, 0xB1, 0xF, 0xF, true); }
__device__ __forceinline__ void store_row_pk(bf16* rowp, int lane, const v2u (&o)[4]) {
    const bool odd = (lane & 1) != 0; bf16* p = rowp + 4 * (lane & ~1) + (odd ? 256 : 0);
#pragma unroll
    for (int pr = 0; pr < 2; ++pr) { const v2u a = o[2 * pr], b = o[2 * pr + 1], send = odd ? a : b; v2u recv; recv.x = dpp_swap1(send.x); recv.y = dpp_swap1(send.y);
        const v4u w = odd ? (v4u){recv.x, recv.y, b.x, b.y} : (v4u){a.x, a.y, recv.x, recv.y};
        *(GAS v4u*)(p + 512 * pr) = w; }
}
struct RowRaw { v4u w[2]; };
__device__ __forceinline__ void load_row_raw(const bf16* rowp, int lane, RowRaw& r) {
    const bf16* p = rowp + 4 * (lane & ~1) + ((lane & 1) ? 256 : 0);
    r.w[0] = *(const GAS v4u*)p; r.w[1] = *(const GAS v4u*)(p + 512);
}
__device__ __forceinline__ void unpack_row_raw(const RowRaw& r, int lane, v2u (&o)[4]) {
    const bool odd = (lane & 1) != 0;
#pragma unroll
    for (int pr = 0; pr < 2; ++pr) { const v4u w = r.w[pr]; const v2u lo = (v2u){w.x, w.y}, hi = (v2u){w.z, w.w}, send = odd ? lo : hi; v2u recv; recv.x = dpp_swap1(send.x); recv.y = dpp_swap1(send.y);
        o[2 * pr] = odd ? recv : lo; o[2 * pr + 1] = odd ? hi : recv; }
}
__device__ __forceinline__ unsigned dpp_swap2(unsigned v) { return (unsigned)__builtin_amdgcn_update_dpp(0, (int)v, 0x4E, 0xF, 0xF, true); }
__device__ __forceinline__ void store_row_q8(unsigned char* rowp, int lane, const unsigned (&d)[4]) {
    const bool o1 = (lane & 1) != 0, o2 = (lane & 2) != 0;
    unsigned p[2][2];
#pragma unroll
    for (int cc = 0; cc < 2; ++cc) { const unsigned keep = o1 ? d[2 * cc + 1] : d[2 * cc], send = o1 ? d[2 * cc] : d[2 * cc + 1], recv = dpp_swap1(send); p[cc][0] = o1 ? recv : keep; p[cc][1] = o1 ? keep : recv; }
    const unsigned s0 = o2 ? p[0][0] : p[1][0], s1 = o2 ? p[0][1] : p[1][1], r0 = dpp_swap2(s0), r1 = dpp_swap2(s1);
    const v4u w = o2 ? (v4u){r0, r1, p[1][0], p[1][1]} : (v4u){p[0][0], p[0][1], r0, r1};
    *(GAS v4u*)(rowp + 16 * (lane >> 2) + 256 * (lane & 3)) = w;
}
__device__ __forceinline__ void store_row_bf16(bf16* p, int lane, const f32x4 (&v)[4]) {
    v2u o[4];
#pragma unroll
    for (int j = 0; j < 4; ++j) { o[j].x = pk2(v[j][0], v[j][1]); o[j].y = pk2(v[j][2], v[j][3]); }
    store_row_pk(p, lane, o);
}
__device__ __forceinline__ void mod_ln_row(const f32x4 (&x)[4], const float* sh, const float* sc, int lane, f32x4 (&u)[4]) {
    float mean, rstd; ln_stats(x, mean, rstd);
#pragma unroll
    for (int j = 0; j < 4; ++j) { const f32x4 s1 = *(const GAS f32x4*)(sc + 4 * lane + 256 * j), s0 = *(const GAS f32x4*)(sh + 4 * lane + 256 * j); u[j] = (x[j] - mean) * rstd * (1.0f + s1) + s0; }
}
__device__ __forceinline__ void p_r0(const Args& a, int gw, int NGW, int lane) {
    const float* mods = (const float*)(a.ws + WS_MODS); bf16* U = (bf16*)(a.ws + WS_U);
    for (int t0 = gw * 4; t0 < T; t0 += NGW * 4) { const int b = t0 / SEQ; const float* mb = mods + (size_t)b * 6 * D;
        f32x4 x[4][4]; float mean[4], rstd[4]; v2u ob[4][4];
#pragma unroll
        for (int r = 0; r < 4; ++r) load_row4(a.in[I_X] + (size_t)(t0 + r) * D, lane, x[r]);
#pragma unroll
        for (int r = 0; r < 4; ++r) ln_stats(x[r], mean[r], rstd[r]);
#pragma unroll
        for (int j = 0; j < 4; ++j) { const f32x4 s1 = *(const GAS f32x4*)(mb + D + 4 * lane + 256 * j), s0 = *(const GAS f32x4*)(mb + 4 * lane + 256 * j);
#pragma unroll
            for (int r = 0; r < 4; ++r) { const f32x4 u = (x[r][j] - mean[r]) * rstd[r] * (1.0f + s1) + s0; ob[r][j].x = pk2(u[0], u[1]); ob[r][j].y = pk2(u[2], u[3]); } }
#pragma unroll
        for (int r = 0; r < 4; ++r) store_row_pk(U + (size_t)(t0 + r) * D, lane, ob[r]);
    }
}

namespace att {
typedef short v4i16_t __attribute__((ext_vector_type(4)));
__device__ __forceinline__ s16x4 vtr(const LAS unsigned char* p) { return __builtin_bit_cast(s16x4, __builtin_amdgcn_ds_read_tr16_b64_v4i16((LAS v4i16_t*)p)); }
__device__ __forceinline__ void glds16(const void* gsrc, unsigned lds_dst) { unsigned keep;
    asm volatile("s_mov_b32 %0, m0\n\ts_mov_b32 m0, %2\n\ts_nop 0\n\tglobal_load_lds_dwordx4 %1, off\n\ts_mov_b32 m0, %0" : "=&s"(keep) : "v"(gsrc), "s"(lds_dst) : "memory"); }
__device__ __forceinline__ void stage_kb(LAS unsigned char* slot, const bf16* qkv, int b, int h, int dil, int res, int kbk, int wave, int lane) {
#pragma unroll
    for (int i = 0; i < 2; ++i) {
        const int blk8 = 2 * wave + i;
        const int kk = 8 * blk8 + (lane >> 3), pos = lane & 7;
        const int t = res + dil * (128 * kbk + kk);
        const char* rowp = (const char*)qkv + ((size_t)(b * SEQ + t) * NIN + AW + h * HD) * 2;
        const int cK = pos ^ ((kk >> 1) & 7), cV = pos ^ (((kk >> 1) & 3) << 1);
        glds16(rowp + cK * 16, (unsigned)(unsigned long)(slot + blk8 * 1024));
        glds16(rowp + AW * 2 + cV * 16, (unsigned)(unsigned long)(slot + 16384 + blk8 * 1024));
    }
}
struct KvOff { unsigned k[2], v[2]; };
__device__ __forceinline__ void make_kvoff(KvOff& o, int dil, int wave, int lane) {
#pragma unroll
    for (int i = 0; i < 2; ++i) { const int blk8 = 2 * wave + i, kk = 8 * blk8 + (lane >> 3), pos = lane & 7;
        const int cK = pos ^ ((kk >> 1) & 7), cV = pos ^ (((kk >> 1) & 3) << 1); const unsigned rowb = (unsigned)(dil * kk) * (unsigned)(NIN * 2);
        o.k[i] = rowb + (unsigned)(cK * 16); o.v[i] = rowb + (unsigned)(AW * 2 + cV * 16); }
}
__device__ __forceinline__ void glds16s(unsigned long long sbase, unsigned voff, unsigned lds_dst) { unsigned keep;
    asm volatile("s_mov_b32 %0, m0\n\ts_mov_b32 m0, %3\n\ts_nop 0\n\tglobal_load_lds_dwordx4 %1, %2\n\ts_mov_b32 m0, %0" : "=&s"(keep) : "v"(voff), "s"(sbase), "s"(lds_dst) : "memory"); }
__device__ __forceinline__ void stage_kbf(LAS unsigned char* slot, const bf16* qkv, int b, int h, int dil, int res, int kbk, int wave, const KvOff& o) {
    const unsigned long long base = (unsigned long long)((const char*)qkv + ((size_t)(b * SEQ + res + dil * 128 * kbk) * NIN + AW + h * HD) * 2);
    const unsigned lo = __builtin_amdgcn_readfirstlane((unsigned)base), hi = __builtin_amdgcn_readfirstlane((unsigned)(base >> 32)); const unsigned long long sb = ((unsigned long long)hi << 32) | lo;
#pragma unroll
    for (int i = 0; i < 2; ++i) { const int blk8 = 2 * wave + i;
        glds16s(sb, o.k[i], (unsigned)(unsigned long)(slot + blk8 * 1024));
        glds16s(sb, o.v[i], (unsigned)(unsigned long)(slot + 16384 + blk8 * 1024)); }
}
__device__ __forceinline__ void load_q(const bf16* qkv, int b, int h, int dil, int res, int n0, int wave, int lane, bf16x8 (&qf)[2]) {
    const int fr = lane & 15, fq = lane >> 4;
    const size_t trow = (size_t)(b * SEQ + res + dil * (n0 + 16 * wave + fr));
    const bf16* qrow = qkv + trow * NIN + h * HD;
#pragma unroll
    for (int s = 0; s < 2; ++s) qf[s] = *(const GAS bf16x8*)(qrow + 32 * s + 8 * fq);
}
__device__ __forceinline__ float mx2(float a, float b) { return __builtin_elementwise_maximum(a, b); }
struct BlkOut { v2u w[4]; float lse; size_t trow; };
struct BlkTab { int kofs0, kofs1, vofs[4]; f32x4 kb[2], kbF[2], kbL[2]; };
template <bool N0, int PAT> __device__ __forceinline__ void make_tab(BlkTab& t, float slope2, int wq, int lane) {
    constexpr int JMIN = PAT == 0 ? 0 : 33;
    const int fr = lane & 15, fq = lane >> 4, qi = 16 * wq + fr;
    const int kt_lo = N0 ? 4 : (wq >> 1), kt_hi = (16 * wq + 143 - JMIN) >> 5;
    const int sw = (fr >> 1) & 7; t.kofs0 = fr * 128 + ((fq ^ sw) << 4); t.kofs1 = fr * 128 + (((4 + fq) ^ sw) << 4);
    const int q4 = fr >> 2, pp = fr & 3, gL = ((2 * fq + (q4 >> 1)) & 3) << 1;
#pragma unroll
    for (int mt = 0; mt < 4; ++mt) t.vofs[mt] = (4 * fq + q4) * 128 + ((((2 * mt) ^ gL) + (pp >> 1)) << 4) + 8 * (pp & 1);
    const int dF = qi + 128 - 32 * kt_lo - 4 * fq, dL = qi + 128 - 32 * kt_hi - 4 * fq;
#pragma unroll
    for (int sub = 0; sub < 2; ++sub)
#pragma unroll
        for (int r = 0; r < 4; ++r) { const int dm = (fr - 4 * fq - r) & 15;
            const float ml = PAT == 0 ? (dm == 0 ? 1.5849625007f : ((dm & 3) == 0 ? 1.0f : 0.0f)) : (PAT == 1 ? ((dm & 3) == 0 ? 1.0f : 0.0f) : 0.0f);
            const float k0 = slope2 * (float)(4 * fq + 16 * sub + r) + ml; t.kb[sub][r] = k0;
            t.kbF[sub][r] = ((unsigned)(dF - 16 * sub - r - JMIN) > (unsigned)(128 - JMIN)) ? -3.0e38f : k0; t.kbL[sub][r] = ((unsigned)(dL - 16 * sub - r - JMIN) > (unsigned)(128 - JMIN)) ? -3.0e38f : k0; }
}
template <bool N0  , int PAT>
__device__ __forceinline__ void block(const LAS unsigned char* slotA, const LAS unsigned char* slotB, const bf16x8 (&qf)[2], BlkOut& bo, int b, int dil, int res, int n0, float slope2, int wq, int lane, const BlkTab& tb) {
    constexpr int JMIN = PAT == 0 ? 0 : 33, NSTEP = PAT == 0 ? 5 : 4;
    const int fr = lane & 15;
    const int qi = 16 * wq + fr;
    const size_t trow = (size_t)(b * SEQ + res + dil * (n0 + qi));
    const int kt_lo = N0 ? 4 : (wq >> 1), kt_hi = (16 * wq + 143 - JMIN) >> 5;
    const int kofs0 = tb.kofs0, kofs1 = tb.kofs1;
    int vofs[4];
#pragma unroll
    for (int mt = 0; mt < 4; ++mt) vofs[mt] = tb.vofs[mt];
    f32x4 kb[2] = {tb.kb[0], tb.kb[1]}, kbF[2] = {tb.kbF[0], tb.kbF[1]}, kbL[2] = {tb.kbL[0], tb.kbL[1]};
    float sc[5][2][4]; float m = -3.0e38f;
#pragma unroll
    for (int j = 0; j < (N0 ? 4 : NSTEP); ++j) {
        const int kt = kt_lo + j;
        if (!N0 || kt <= kt_hi) {
            f32x4 s[2];
#define ATT_QK(TAB) do { _Pragma("unroll") for (int sub = 0; sub < 2; ++sub) { \
                const int rb = 32 * kt + 16 * sub; const LAS unsigned char* kp = (rb < 128 ? slotA : slotB) + (rb & 127) * 128; \
                const bf16x8 k0 = *(const LAS bf16x8*)(kp + kofs0), k1 = *(const LAS bf16x8*)(kp + kofs1); \
                s[sub] = __builtin_amdgcn_mfma_f32_16x16x32_bf16(k1, qf[1], __builtin_amdgcn_mfma_f32_16x16x32_bf16(k0, qf[0], TAB[sub], 0, 0, 0), 0, 0, 0); } } while (0)
            if ((!N0 && j == NSTEP - 1) || (N0 && kt == kt_hi)) ATT_QK(kbL); else if (!N0 && j == 0) ATT_QK(kbF); else ATT_QK(kb);
#undef ATT_QK
#pragma unroll
            for (int sub = 0; sub < 2; ++sub)
#pragma unroll
                for (int r = 0; r < 4; ++r) sc[j][sub][r] = s[sub][r];
            const float off = slope2 * (float)(32 * kt);
            const float mj = mx2(mx2(mx2(sc[j][0][0], sc[j][0][1]), mx2(sc[j][0][2], sc[j][0][3])), mx2(mx2(sc[j][1][0], sc[j][1][1]), mx2(sc[j][1][2], sc[j][1][3])));
            m = mx2(m, mj + off);
        }
    }
    { const unsigned mi = __builtin_bit_cast(unsigned, m); const auto t = __builtin_amdgcn_permlane16_swap(mi, mi, false, false);
      m = mx2(__builtin_bit_cast(float, (unsigned)t[0]), __builtin_bit_cast(float, (unsigned)t[1]));
      const unsigned m1 = __builtin_bit_cast(unsigned, m); const auto u = __builtin_amdgcn_permlane32_swap(m1, m1, false, false);
      m = mx2(__builtin_bit_cast(float, (unsigned)u[0]), __builtin_bit_cast(float, (unsigned)u[1])); }
    bf16x8 pf[5];
#pragma unroll
    for (int j = 0; j < (N0 ? 4 : NSTEP); ++j) {
        const int kt = kt_lo + j;
        if (!N0 || kt <= kt_hi) {
            const float om = slope2 * (float)(32 * kt) - m; const f32x2 om2 = (f32x2){om, om};
            f32x2 p2[4];
#pragma unroll
            for (int sub = 0; sub < 2; ++sub)
#pragma unroll
                for (int h2 = 0; h2 < 2; ++h2) { const f32x2 a2 = (f32x2){sc[j][sub][2 * h2], sc[j][sub][2 * h2 + 1]} + om2; p2[2 * sub + h2] = (f32x2){ex2(a2[0]), ex2(a2[1])}; }
            v4u pw; pw.x = pk2v(p2[0][0], p2[0][1]); pw.y = pk2v(p2[1][0], p2[1][1]); pw.z = pk2v(p2[2][0], p2[2][1]); pw.w = pk2v(p2[3][0], p2[3][1]);
            pf[j] = __builtin_bit_cast(bf16x8, pw);
        }
    }
    f32x4 o[4], l4 = (f32x4){0.f, 0.f, 0.f, 0.f};
#pragma unroll
    for (int mt = 0; mt < 4; ++mt) o[mt] = (f32x4){0.f, 0.f, 0.f, 0.f};
    const bf16x8 ones = (bf16x8){0x3f80, 0x3f80, 0x3f80, 0x3f80, 0x3f80, 0x3f80, 0x3f80, 0x3f80};
#pragma unroll
    for (int j = 0; j < (N0 ? 4 : NSTEP); ++j) {
        const int kt = kt_lo + j;
        if (!N0 || kt <= kt_hi) {
            const int rb = 32 * kt; const LAS unsigned char* vb = (rb < 128 ? slotA : slotB) + 16384 + (rb & 127) * 128;
            l4 = __builtin_amdgcn_mfma_f32_16x16x32_bf16(ones, pf[j], l4, 0, 0, 0);
#pragma unroll
            for (int mt = 0; mt < 4; ++mt) {
                const s16x4 lo = vtr(vb + vofs[mt]), hi = vtr(vb + vofs[mt] + 2048);
                const bf16x8 vf = __builtin_shufflevector(lo, hi, 0, 1, 2, 3, 4, 5, 6, 7);
                o[mt] = __builtin_amdgcn_mfma_f32_16x16x32_bf16(vf, pf[j], o[mt], 0, 0, 0);
            }
        }
    }
    const float l = l4[0], inv = l > 0.f ? __builtin_amdgcn_rcpf(l) : 0.f;
#pragma unroll
    for (int mt = 0; mt < 4; ++mt) { bo.w[mt].x = pk2(o[mt][0] * inv, o[mt][1] * inv); bo.w[mt].y = pk2(o[mt][2] * inv, o[mt][3] * inv); }
    bo.lse = l > 0.f ? m + __builtin_amdgcn_logf(l) - slope2 * (float)(128 + qi) : -3.0e38f; bo.trow = trow;
}
__device__ __forceinline__ void store_out(const BlkOut& bo, bf16* outp, float* lsep, int h, int lane) {
    const int fq = lane >> 4, odd = fq & 1; bf16* orow = outp + bo.trow * AW + h * HD + 4 * (fq & ~1) + 16 * odd;
#pragma unroll
    for (int pr = 0; pr < 2; ++pr) { const auto sx = __builtin_amdgcn_permlane16_swap(bo.w[2 * pr].x, bo.w[2 * pr + 1].x, false, false), sy = __builtin_amdgcn_permlane16_swap(bo.w[2 * pr].y, bo.w[2 * pr + 1].y, false, false);
        *(GAS v4u*)(orow + 32 * pr) = (v4u){(unsigned)sx[0], (unsigned)sy[0], (unsigned)sx[1], (unsigned)sy[1]}; }
    if (fq == 0) lsep[bo.trow * NH + h] = bo.lse;
}
template <int PAT> __device__ __forceinline__ int ticket_p(LAS unsigned char* lds, const Args& a, int tk, int wave, int lane, unsigned* qctr) {
    const bf16* qkv = (const bf16*)(a.ws + WS_QKV);
    constexpr int patt = PAT; const int bh = tk / 6, rem = tk % 6, half = rem & 1, b = bh / NH, h = bh % NH;
    const int dil = patt == 0 ? 1 : (patt == 1 ? 4 : 16);
    const float slope = h < 8 ? exp2f(-(float)(h + 1)) : exp2f(-(0.5f + (float)(h - 8)));
    const float slope2 = slope * (float)dil * LOG2E;
    bf16* outp = (bf16*)(a.ws + WS_ATTP) + (size_t)patt * T * AW; float* lsep = (float*)(a.ws + WS_LSE) + (size_t)patt * T * NH;
    const int e0 = (patt == 0 && half == 1) ? 1 : 0, NL = 8 + e0;
    int res, qb, kres, kbk;
#define ATT_VMW "s_waitcnt vmcnt(4)"
#define ATT_DESC(j) do { if (patt == 0) { res = 0; qb = 8 * half + (j); } else if (patt == 1) { res = 2 * half + ((j) >> 2); qb = (j) & 3; } else { res = 8 * half + (j); qb = 0; } } while (0)
#define ATT_LOAD(i) do { if (patt == 0) { kres = 0; kbk = 8 * half - e0 + (i); } else if (patt == 1) { kres = 2 * half + ((i) >> 2); kbk = (i) & 3; } else { kres = 8 * half + (i); kbk = 0; } \
        stage_kbf(lds + ((i) & 3) * 32768, qkv, b, h, dil, kres, kbk, wave, kvo); } while (0)
    KvOff kvo; make_kvoff(kvo, dil, wave, lane);
    for (int i = 0; i <= e0 + 1; ++i) ATT_LOAD(i);
    bf16x8 qn[2]; ATT_DESC(0); load_q(qkv, b, h, dil, res, 128 * qb, wave, lane, qn);
    BlkOut bo; bool have_out = false, dma_last = true; int nxt = -1;
    BlkTab tbc; make_tab<false, PAT>(tbc, slope2, wave, lane);
    BlkTab tbn; if constexpr (PAT == 1) make_tab<true, PAT>(tbn, slope2, wave, lane);
    for (int j = 0; j < 8; ++j) {
        const int lane_o = lane;
        const int ib = j + e0;
        if (dma_last) asm volatile(ATT_VMW ::: "memory"); else asm volatile("s_waitcnt vmcnt(0)" ::: "memory");
        __syncthreads();
        bf16x8 qf[2] = {qn[0], qn[1]};
        ATT_DESC(j); const int res_j = res, qb_j = qb;
        if (have_out) store_out(bo, outp, lsep, h, lane_o);
        if (j + 1 < 8) { ATT_DESC(j + 1); load_q(qkv, b, h, dil, res, 128 * qb, wave, lane_o, qn); }
        asm volatile("" ::: "memory");
        if (ib + 2 < NL) { ATT_LOAD(ib + 2); dma_last = true; } else dma_last = false;
        if (j == 7 && wave == 0 && lane_o == 0) nxt = (int)__hip_atomic_fetch_add(qctr, 1u, RLX_AGENT);
        asm volatile("" ::: "memory");
        const LAS unsigned char* sA = lds + ((ib + 3) & 3) * 32768; const LAS unsigned char* sB = lds + (ib & 3) * 32768;
        if (qb_j == 0) { if constexpr (PAT == 1) block<true, PAT>(sA, sB, qf, bo, b, dil, res_j, 0, slope2, wave, lane_o, tbn);
            else { BlkTab t0; make_tab<true, PAT>(t0, slope2, wave, lane_o); block<true, PAT>(sA, sB, qf, bo, b, dil, res_j, 0, slope2, wave, lane_o, t0); } }
        else block<false, PAT>(sA, sB, qf, bo, b, dil, res_j, 128 * qb_j, slope2, wave, lane_o, tbc);
        have_out = true;
    }
    store_out(bo, outp, lsep, h, lane);
    return nxt;
#undef ATT_DESC
#undef ATT_LOAD
}
__device__ __forceinline__ int ticket_p2(LAS unsigned char* lds, const Args& a, int tk, int wave, int lane, unsigned* qctr) {
    const bf16* qkv = (const bf16*)(a.ws + WS_QKV);
    const int bh = tk / 6, half = (tk % 6) & 1, b = bh / NH, h = bh % NH;
    constexpr int dil = 16;
    const float slope = h < 8 ? exp2f(-(float)(h + 1)) : exp2f(-(0.5f + (float)(h - 8)));
    const float slope2 = slope * (float)dil * LOG2E;
    bf16* outp = (bf16*)(a.ws + WS_ATTP) + (size_t)2 * T * AW; float* lsep = (float*)(a.ws + WS_LSE) + (size_t)2 * T * NH;
    const int sel = wave & 1, pr = wave >> 1, g1 = 7 - pr, g2 = pr; const bool two = pr >= 2;
    KvOff kvo; make_kvoff(kvo, dil, wave, lane);
    stage_kbf(lds, qkv, b, h, dil, 8 * half, 0, wave, kvo); stage_kbf(lds + 32768, qkv, b, h, dil, 8 * half + 1, 0, wave, kvo);
    bf16x8 qn1[2], qn2[2]; load_q(qkv, b, h, dil, 8 * half + sel, 0, g1, lane, qn1); load_q(qkv, b, h, dil, 8 * half + sel, 0, g2, lane, qn2);
    BlkOut bo1, bo2; bool have_out = false; int nxt = -1;
    BlkTab t1, t2; make_tab<true, 2>(t1, slope2, g1, lane); make_tab<true, 2>(t2, slope2, g2, lane);
    for (int s = 0; s < 4; ++s) {
        const int lane_o = lane;
        asm volatile("s_waitcnt vmcnt(0)" ::: "memory");
        __syncthreads();
        bf16x8 qf1[2] = {qn1[0], qn1[1]}, qf2[2] = {qn2[0], qn2[1]};
        const int res = 8 * half + 2 * s + sel;
        if (have_out) { store_out(bo1, outp, lsep, h, lane_o); store_out(bo2, outp, lsep, h, lane_o); }
        if (s + 1 < 4) { load_q(qkv, b, h, dil, res + 2, 0, g1, lane_o, qn1); load_q(qkv, b, h, dil, res + 2, 0, g2, lane_o, qn2);
            asm volatile("" ::: "memory");
            stage_kbf(lds + ((2 * s + 2) & 3) * 32768, qkv, b, h, dil, 8 * half + 2 * s + 2, 0, wave, kvo); stage_kbf(lds + ((2 * s + 3) & 3) * 32768, qkv, b, h, dil, 8 * half + 2 * s + 3, 0, wave, kvo); }
        asm volatile("" ::: "memory");
        if (s == 3 && wave == 0 && lane_o == 0) nxt = (int)__hip_atomic_fetch_add(qctr, 1u, RLX_AGENT);
        const LAS unsigned char* slot = lds + ((2 * s + sel) & 3) * 32768;
        block<true, 2>(slot, slot, qf1, bo1, b, dil, res, 0, slope2, g1, lane_o, t1);
        if (two) block<true, 2>(slot, slot, qf2, bo2, b, dil, res, 0, slope2, g2, lane_o, t2);
        else { bo2.w[0] = bo2.w[1] = bo2.w[2] = bo2.w[3] = (v2u){0u, 0u}; bo2.lse = -3.0e38f; bo2.trow = (size_t)(b * SEQ + res + dil * (16 * g2 + (lane_o & 15))); }
        have_out = true;
    }
    store_out(bo1, outp, lsep, h, lane); store_out(bo2, outp, lsep, h, lane);
    return nxt;
}
__device__ __forceinline__ int ticket(LAS unsigned char* lds, const Args& a, int tk, int wave, int lane, unsigned* qctr) {
    const int patt = (tk % 6) >> 1;
    if (patt == 0) return ticket_p<0>(lds, a, tk, wave, lane, qctr); else if (patt == 1) return ticket_p<1>(lds, a, tk, wave, lane, qctr); else return ticket_p2(lds, a, tk, wave, lane, qctr);
}
}
namespace lru {
constexpr int XC_OFF = 0, XCF_OFF = 16384, XG_OFF = XCF_OFF + 128 * 68 * 4, OUT_OFF = XG_OFF + 128 * 72 * 2, AGG_OFF = OUT_OFF + 128 * 72 * 2, WF_OFF = AGG_OFF + 4096, CWL_OFF = WF_OFF + 16384;
static_assert(CWL_OFF + 1280 <= RING_BYTES, "lru lds");
__device__ __forceinline__ void unit(LAS unsigned char* lds, const Args& a, int l, int tk, int wave, int lane, int tid) {
    const int b = tk >> 2, blk = tk & 3, fr = lane & 15, fq = lane >> 4;
    const bf16* qkv = (const bf16*)(a.ws + WS_QKV); bf16* outg = (bf16*)(a.ws + WS_LRU);
    LAS v4u* WF = (LAS v4u*)(lds + WF_OFF);
    {
#pragma unroll
      for (int ff = 0; ff < 2; ++ff) { const int f = 2 * wave + ff, gate = f >> 3, nt = (f >> 1) & 3, s = f & 1;
        const float* W = (gate ? a.in[I_WX] : a.in[I_WA]) + ((size_t)l * 4 + blk) * 64 * 64;
        const int k0 = 32 * s + 8 * fq, oc = 16 * nt + fr; v4u pa;
        pa.x = pk2(W[(k0 + 0) * 64 + oc], W[(k0 + 1) * 64 + oc]); pa.y = pk2(W[(k0 + 2) * 64 + oc], W[(k0 + 3) * 64 + oc]); pa.z = pk2(W[(k0 + 4) * 64 + oc], W[(k0 + 5) * 64 + oc]); pa.w = pk2(W[(k0 + 6) * 64 + oc], W[(k0 + 7) * 64 + oc]);
        WF[f * 64 + lane] = pa; } }
    float ba[4], bx[4], csp[4], carry[4];
#pragma unroll
    for (int nt = 0; nt < 4; ++nt) { const int ch = l * LW + 64 * blk + 16 * nt + fr; ba[nt] = a.in[I_BA][ch]; bx[nt] = a.in[I_BX][ch]; csp[nt] = 8.0f * log1pf(expf(-a.in[I_LAM][ch])); carry[nt] = 0.f; }
    const int c8 = tid & 7, chb = 64 * blk + 8 * c8;
    LAS unsigned char* XC = lds + XC_OFF; LAS float* XCF = (LAS float*)(lds + XCF_OFF); LAS bf16* XG = (LAS bf16*)(lds + XG_OFF); LAS bf16* OUT = (LAS bf16*)(lds + OUT_OFF); LAS float* AGG = (LAS float*)(lds + AGG_OFF);
    LAS float* CWL = (LAS float*)(lds + CWL_OFF);
    if (tid < 320) { const int j = tid >> 6, ch = tid & 63; CWL[tid] = j < 4 ? a.in[I_CONVW][((size_t)l * 4 + j) * LW + 64 * blk + ch] : a.in[I_CONVB][l * LW + 64 * blk + ch]; }
    __syncthreads();
    v4u px[5], pg[2];
#define LRU_FETCH(tile_) do { const int s0 = 128 * (tile_) + 2 * (tid >> 3); const bf16* rowp = qkv + (size_t)(b * SEQ + s0) * NIN + 2304 + chb; \
        _Pragma("unroll") for (int k = 0; k < 5; ++k) { px[k] = (v4u){0u, 0u, 0u, 0u}; if (s0 - 3 + k >= 0) px[k] = *(const GAS v4u*)(rowp + ((ptrdiff_t)k - 3) * NIN); } \
        pg[0] = *(const GAS v4u*)(rowp + LW); pg[1] = *(const GAS v4u*)(rowp + NIN + LW); } while (0)
    LRU_FETCH(0);
    for (int tile = 0; tile < 16; ++tile) {
#pragma unroll
        for (int it = 0; it < 2; ++it) {
            const int ti = 2 * (tid >> 3) + it;
            float xc[8];
            { const f32x4 c0 = *(const LAS f32x4*)(CWL + 256 + 8 * c8), c1 = *(const LAS f32x4*)(CWL + 256 + 8 * c8 + 4); xc[0] = c0[0]; xc[1] = c0[1]; xc[2] = c0[2]; xc[3] = c0[3]; xc[4] = c1[0]; xc[5] = c1[1]; xc[6] = c1[2]; xc[7] = c1[3]; }
#pragma unroll
            for (int j = 0; j < 4; ++j) { const v4u xr = px[it + j]; const f32x4 w0 = *(const LAS f32x4*)(CWL + 64 * j + 8 * c8), w1 = *(const LAS f32x4*)(CWL + 64 * j + 8 * c8 + 4);
                xc[0] += w0[0] * bf_lo(xr.x); xc[1] += w0[1] * bf_hi(xr.x); xc[2] += w0[2] * bf_lo(xr.y); xc[3] += w0[3] * bf_hi(xr.y);
                xc[4] += w1[0] * bf_lo(xr.z); xc[5] += w1[1] * bf_hi(xr.z); xc[6] += w1[2] * bf_lo(xr.w); xc[7] += w1[3] * bf_hi(xr.w); }
            v4u xb; xb.x = pk2(xc[0], xc[1]); xb.y = pk2(xc[2], xc[3]); xb.z = pk2(xc[4], xc[5]); xb.w = pk2(xc[6], xc[7]);
            *(LAS v4u*)(XC + ti * 128 + ((c8 ^ ((ti >> 1) & 7)) << 4)) = xb;
            *(LAS f32x4*)(XCF + ti * 68 + 8 * c8) = (f32x4){xc[0], xc[1], xc[2], xc[3]}; *(LAS f32x4*)(XCF + ti * 68 + 8 * c8 + 4) = (f32x4){xc[4], xc[5], xc[6], xc[7]};
            *(LAS v4u*)(XG + ti * 72 + 8 * c8) = pg[it];
        }
        if (tile + 1 < 16) LRU_FETCH(tile + 1);
        __syncthreads();
        f32x4 ga[4], gx[4];
        { const int tok = 16 * wave + fr, sw = (tok >> 1) & 7;
          const bf16x8 a0 = *(const LAS bf16x8*)(XC + tok * 128 + ((fq ^ sw) << 4)), a1 = *(const LAS bf16x8*)(XC + tok * 128 + (((4 + fq) ^ sw) << 4));
#pragma unroll
          for (int nt = 0; nt < 4; ++nt) { f32x4 z = (f32x4){0.f, 0.f, 0.f, 0.f};
              const bf16x8 wa0 = __builtin_bit_cast(bf16x8, WF[(nt * 2 + 0) * 64 + lane]), wa1 = __builtin_bit_cast(bf16x8, WF[(nt * 2 + 1) * 64 + lane]);
              const bf16x8 wx0 = __builtin_bit_cast(bf16x8, WF[(8 + nt * 2 + 0) * 64 + lane]), wx1 = __builtin_bit_cast(bf16x8, WF[(8 + nt * 2 + 1) * 64 + lane]);
              ga[nt] = __builtin_amdgcn_mfma_f32_16x16x32_bf16(a1, wa1, __builtin_amdgcn_mfma_f32_16x16x32_bf16(a0, wa0, z, 0, 0, 0), 0, 0, 0);
              gx[nt] = __builtin_amdgcn_mfma_f32_16x16x32_bf16(a1, wx1, __builtin_amdgcn_mfma_f32_16x16x32_bf16(a0, wx0, z, 0, 0, 0), 0, 0, 0); } }
        float av[4][4], bv[4][4], Aex[4], Hex[4];
#pragma unroll
        for (int nt = 0; nt < 4; ++nt) {
            const int ch = 16 * nt + fr; float A4 = 1.f, H4 = 0.f;
#pragma unroll
            for (int r = 0; r < 4; ++r) { const int tok2 = 16 * wave + 4 * fq + r;
                const float rg = sigmoidf_(ga[nt][r] + ba[nt]), ig = sigmoidf_(gx[nt][r] + bx[nt]);
                const float la = -csp[nt] * rg, x2 = 2.0f * la, aa = ex2(la * LOG2E);
                const float ser = -x2 * (1.0f + x2 * (0.5f + x2 * (0.16666667f + x2 * (0.041666668f + x2 * 0.0083333338f))));
                const float om = (x2 > -0.3f) ? ser : (1.0f - aa * aa);
                const float bb = __builtin_amdgcn_sqrtf(om) * ig * XCF[tok2 * 68 + ch];
                av[nt][r] = aa; bv[nt][r] = bb; H4 = aa * H4 + bb; A4 *= aa; }
            float Ap = __shfl_up(A4, 16), Hp = __shfl_up(H4, 16); if (fq >= 1) { H4 = A4 * Hp + H4; A4 = A4 * Ap; }
            Ap = __shfl_up(A4, 32); Hp = __shfl_up(H4, 32); if (fq >= 2) { H4 = A4 * Hp + H4; A4 = A4 * Ap; }
            Aex[nt] = __shfl_up(A4, 16); Hex[nt] = __shfl_up(H4, 16); if (fq == 0) { Aex[nt] = 1.f; Hex[nt] = 0.f; }
            if (fq == 3) { AGG[(wave * 64 + ch) * 2] = A4; AGG[(wave * 64 + ch) * 2 + 1] = H4; }
        }
        __syncthreads();
#pragma unroll
        for (int nt = 0; nt < 4; ++nt) {
            const int ch = 16 * nt + fr; float h = carry[nt], hw = carry[nt];
#pragma unroll
            for (int w2 = 0; w2 < 8; ++w2) { if (w2 == wave) hw = h; const float A = AGG[(w2 * 64 + ch) * 2], H = AGG[(w2 * 64 + ch) * 2 + 1]; h = A * h + H; }
            carry[nt] = h;
            float hl = Aex[nt] * hw + Hex[nt];
#pragma unroll
            for (int r = 0; r < 4; ++r) { const int tok2 = 16 * wave + 4 * fq + r; hl = av[nt][r] * hl + bv[nt][r];
                const float g = __builtin_bit_cast(float, (unsigned)XG[tok2 * 72 + ch] << 16);
                const float y = hl * g * sigmoidf_(1.5957691216f * (g + 0.044715f * g * g * g));
                OUT[tok2 * 72 + ch] = (bf16)f2bf(y); }
        }
        __syncthreads();
#pragma unroll
        for (int it = 0; it < 2; ++it) { const int ti = (tid >> 3) + 64 * it, s = 128 * tile + ti;
            *(GAS v4u*)(outg + (size_t)(b * SEQ + s) * LW + chb) = *(const LAS v4u*)(OUT + ti * 72 + 8 * c8); }
    }
#undef LRU_FETCH
}
}

__device__ __forceinline__ void merge_chunk(const bf16* ATTP, const float* LSE, int t, int c, float (&v)[8]) {
    const int head = c >> 3;
    const float l0 = LSE[(size_t)t * NH + head], l1 = LSE[(size_t)T * NH + (size_t)t * NH + head], l2 = LSE[(size_t)2 * T * NH + (size_t)t * NH + head];
    const float mx = fmaxf(l0, fmaxf(l1, l2)); float w0 = ex2(l0 - mx), w1 = ex2(l1 - mx), w2 = ex2(l2 - mx); const float inv = 1.0f / (w0 + w1 + w2); w0 *= inv; w1 *= inv; w2 *= inv;
    const v4u p0 = *(const GAS v4u*)(ATTP + (size_t)t * AW + 8 * c), p1 = *(const GAS v4u*)(ATTP + (size_t)T * AW + (size_t)t * AW + 8 * c), p2 = *(const GAS v4u*)(ATTP + (size_t)2 * T * AW + (size_t)t * AW + 8 * c);
    v[0] = w0 * bf_lo(p0.x) + w1 * bf_lo(p1.x) + w2 * bf_lo(p2.x); v[1] = w0 * bf_hi(p0.x) + w1 * bf_hi(p1.x) + w2 * bf_hi(p2.x);
    v[2] = w0 * bf_lo(p0.y) + w1 * bf_lo(p1.y) + w2 * bf_lo(p2.y); v[3] = w0 * bf_hi(p0.y) + w1 * bf_hi(p1.y) + w2 * bf_hi(p2.y);
    v[4] = w0 * bf_lo(p0.z) + w1 * bf_lo(p1.z) + w2 * bf_lo(p2.z); v[5] = w0 * bf_hi(p0.z) + w1 * bf_hi(p1.z) + w2 * bf_hi(p2.z);
    v[6] = w0 * bf_lo(p0.w) + w1 * bf_lo(p1.w) + w2 * bf_lo(p2.w); v[7] = w0 * bf_hi(p0.w) + w1 * bf_hi(p1.w) + w2 * bf_hi(p2.w);
}
constexpr int MRG = 2;
__device__ __forceinline__ void p_merge(const Args& a, int l, int gw, int NGW, int lane) {
    const bf16* ATTP = (const bf16*)(a.ws + WS_ATTP); const float* LSE = (const float*)(a.ws + WS_LSE); const bf16* LRU = (const bf16*)(a.ws + WS_LRU); bf16* A2 = (bf16*)(a.ws + WS_U);
    const float* ang = a.in[I_ANG] + l * AW; const float* lng = a.in[I_LNG] + l * LW;
    const bool at1 = lane < 32;
    const float* g0 = ang + 8 * lane; const float* g1 = at1 ? ang + 512 + 8 * lane : lng + 8 * (lane - 32);
    float gg0[8], gg1[8];
#pragma unroll
    for (int k = 0; k < 8; ++k) { gg0[k] = g0[k]; gg1[k] = g1[k]; }
    for (int t0 = gw * MRG; t0 < T; t0 += NGW * MRG) {
        float v0[MRG][8], v1[MRG][8];
#pragma unroll
        for (int r = 0; r < MRG; ++r) { const int t = t0 + r;
            merge_chunk(ATTP, LSE, t, lane, v0[r]);
            if (at1) merge_chunk(ATTP, LSE, t, 64 + lane, v1[r]);
            else { const v4u p = *(const GAS v4u*)(LRU + (size_t)t * LW + 8 * (lane - 32)); v1[r][0] = bf_lo(p.x); v1[r][1] = bf_hi(p.x); v1[r][2] = bf_lo(p.y); v1[r][3] = bf_hi(p.y); v1[r][4] = bf_lo(p.z); v1[r][5] = bf_hi(p.z); v1[r][6] = bf_lo(p.w); v1[r][7] = bf_hi(p.w); } }
#pragma unroll
        for (int r = 0; r < MRG; ++r) { const int t = t0 + r;
            float s0 = 0.f, s1 = 0.f;
#pragma unroll
            for (int k = 0; k < 8; ++k) { s0 += v0[r][k] * v0[r][k]; s1 += v1[r][k] * v1[r][k]; }
            const float ssa = wave_sum(s0 + (at1 ? s1 : 0.f)), ssl = wave_sum(at1 ? 0.f : s1);
            const float ra = rsqrtf(ssa * (1.0f / AW) + RMS_EPS), rl = rsqrtf(ssl * (1.0f / LW) + RMS_EPS); const float r1 = at1 ? ra : rl;
            v4u o0, o1;
            o0.x = pk2(v0[r][0] * ra * gg0[0], v0[r][1] * ra * gg0[1]); o0.y = pk2(v0[r][2] * ra * gg0[2], v0[r][3] * ra * gg0[3]); o0.z = pk2(v0[r][4] * ra * gg0[4], v0[r][5] * ra * gg0[5]); o0.w = pk2(v0[r][6] * ra * gg0[6], v0[r][7] * ra * gg0[7]);
            o1.x = pk2(v1[r][0] * r1 * gg1[0], v1[r][1] * r1 * gg1[1]); o1.y = pk2(v1[r][2] * r1 * gg1[2], v1[r][3] * r1 * gg1[3]); o1.z = pk2(v1[r][4] * r1 * gg1[4], v1[r][5] * r1 * gg1[5]); o1.w = pk2(v1[r][6] * r1 * gg1[6], v1[r][7] * r1 * gg1[7]);
            *(GAS v4u*)(A2 + (size_t)t * D + 8 * lane) = o0; *(GAS v4u*)(A2 + (size_t)t * D + 512 + 8 * lane) = o1; }
    }
}

typedef _Float16 f16x8 __attribute__((ext_vector_type(8)));
typedef __fp16 h16x2 __attribute__((ext_vector_type(2)));
constexpr int R2_UH = 0, R2_UL = 32768, R2_PART = 65536, R2_LOG = 81920, R2_PAR = 83968, R2_TOP = 106496;
__device__ __forceinline__ float row16_max(float v) { v = fmaxf(v, dpp_f<0xB1>(v)); v = fmaxf(v, dpp_f<0x4E>(v)); v = fmaxf(v, dpp_f<0x141>(v)); v = fmaxf(v, dpp_f<0x140>(v)); return v; }
__device__ __forceinline__ void p_r2(const Args& a, LAS unsigned char* lds, volatile LAS unsigned* MISC, int l, int wg, int G, int wave, int lane, int tid) {
    const int fr = lane & 15, fq = lane >> 4;
    f16x8 bh[4][2], bl[4][2];
    { const float* rw = a.in[I_RW] + (size_t)l * D * NE;
#pragma unroll
      for (int s = 0; s < 4; ++s)
#pragma unroll
        for (int nt = 0; nt < 2; ++nt)
#pragma unroll
            for (int j = 0; j < 8; ++j) { const float w = rw[(size_t)(32 * (4 * wave + s) + 8 * fq + j) * NE + 16 * nt + fr]; const _Float16 hi = (_Float16)w; bh[s][nt][j] = hi; bl[s][nt][j] = (_Float16)(w - (float)hi); } }
    const float* mods = (const float*)(a.ws + WS_MODS); const float* xin = a.in[I_X]; const bf16* xbf = (const bf16*)(a.ws + WS_X);
    const bf16* MIX = (const bf16*)(a.ws + WS_MIX); bf16* X1 = (bf16*)(a.ws + WS_X1); unsigned char* U8 = a.ws + WS_U8;
    int* TOPI = (int*)(a.ws + WS_TOPI); float* TOPW = (float*)(a.ws + WS_TOPW); unsigned* WGB = (unsigned*)(a.ws + WS_WGB);
    unsigned* etot = (unsigned*)(a.ws + WS_CTL) + CW_ETOT + 64 * l;
    const float* l1g = a.in[I_LN1G] + l * D; const float* l1b = a.in[I_LN1B] + l * D; const float rbias = a.in[I_RB][l * NE + (tid & 31)];
    LAS float* PART = (LAS float*)(lds + R2_PART); LAS float* LOG = (LAS float*)(lds + R2_LOG);
    for (int chunk = wg; chunk < T / 256; chunk += G) {
        if (tid < 32) MISC[MW_HIST + tid] = 0u;
        { const int bch = (256 * chunk) / SEQ; const float* mbc = mods + ((size_t)l * BATCH + bch) * 6 * D; LAS f32x4* PV = (LAS f32x4*)(lds + R2_PAR);
          for (int i = tid; i < 5 * 256; i += 512) { const int v = i >> 8, q = i & 255; const float* src = v == 0 ? mbc + 2 * D : v == 1 ? l1g : v == 2 ? l1b : v == 3 ? mbc + 4 * D : mbc + 3 * D; PV[i] = *(const GAS f32x4*)(src + 4 * q); } }
        __syncthreads();
        RowRaw xpre[2], mpre[2];
#pragma unroll
        for (int r = 0; r < 2; ++r) { const size_t o = (size_t)(256 * chunk + 2 * wave + r) * D; load_row_raw(MIX + o, lane, mpre[r]); if (l != 0) load_row_raw(xbf + o, lane, xpre[r]); else { xpre[r].w[0] = xpre[r].w[1] = (v4u){0u, 0u, 0u, 0u}; } }
        for (int it = 0; it < 16; ++it) {
            const int tb = 256 * chunk + 16 * it, t0 = tb + 2 * wave, b = t0 / SEQ; const float* mb = mods + ((size_t)l * BATCH + b) * 6 * D;
            f32x4 x[2][4], u[2][4]; v2u mw[2][4], ob[2][4]; unsigned uq[2][4];
#pragma unroll
            for (int r = 0; r < 2; ++r) {
                if (l == 0) load_row4(xin + (size_t)(t0 + r) * D, lane, x[r]);
                else { v2u xw[4]; unpack_row_raw(xpre[r], lane, xw);
#pragma unroll
                    for (int j = 0; j < 4; ++j) x[r][j] = (f32x4){bf_lo(xw[j].x), bf_hi(xw[j].x), bf_lo(xw[j].y), bf_hi(xw[j].y)}; }
                unpack_row_raw(mpre[r], lane, mw[r]); }
            if (it + 1 < 16) {
#pragma unroll
                for (int r = 0; r < 2; ++r) { load_row_raw(MIX + (size_t)(t0 + 16 + r) * D, lane, mpre[r]); if (l != 0) load_row_raw(xbf + (size_t)(t0 + 16 + r) * D, lane, xpre[r]); } }
#pragma unroll
            for (int j = 0; j < 4; ++j) { const f32x4 g1 = *(const LAS f32x4*)(lds + R2_PAR + (0 * 256 + lane + 64 * j) * 16);
#pragma unroll
                for (int r = 0; r < 2; ++r) { const f32x4 mx = (f32x4){bf_lo(mw[r][j].x), bf_hi(mw[r][j].x), bf_lo(mw[r][j].y), bf_hi(mw[r][j].y)}; x[r][j] = ALPHA * x[r][j] + (1.0f + g1) * mx; } }
            float mean[2], rstd[2];
#pragma unroll
            for (int r = 0; r < 2; ++r) ln_stats(x[r], mean[r], rstd[r]);
#pragma unroll
            for (int j = 0; j < 4; ++j) { const f32x4 g = *(const LAS f32x4*)(lds + R2_PAR + (1 * 256 + lane + 64 * j) * 16), bb = *(const LAS f32x4*)(lds + R2_PAR + (2 * 256 + lane + 64 * j) * 16);
#pragma unroll
                for (int r = 0; r < 2; ++r) { x[r][j] = (x[r][j] - mean[r]) * rstd[r] * g + bb; ob[r][j].x = pk2(x[r][j][0], x[r][j][1]); ob[r][j].y = pk2(x[r][j][2], x[r][j][3]); } }
#pragma unroll
            for (int r = 0; r < 2; ++r) store_row_pk(X1 + (size_t)(t0 + r) * D, lane, ob[r]);
#pragma unroll
            for (int r = 0; r < 2; ++r) ln_stats(x[r], mean[r], rstd[r]);
#pragma unroll
            for (int j = 0; j < 4; ++j) { const f32x4 s1 = *(const LAS f32x4*)(lds + R2_PAR + (3 * 256 + lane + 64 * j) * 16), s0 = *(const LAS f32x4*)(lds + R2_PAR + (4 * 256 + lane + 64 * j) * 16);
#pragma unroll
                for (int r = 0; r < 2; ++r) { u[r][j] = (x[r][j] - mean[r]) * rstd[r] * (1.0f + s1) + s0;
                    uq[r][j] = pk4_fp8(u[r][j][0] * F8_SA1, u[r][j][1] * F8_SA1, u[r][j][2] * F8_SA1, u[r][j][3] * F8_SA1);
                    const h16x2 h0 = __builtin_amdgcn_cvt_pkrtz(u[r][j][0], u[r][j][1]), h1 = __builtin_amdgcn_cvt_pkrtz(u[r][j][2], u[r][j][3]);
                    const h16x2 l0 = __builtin_amdgcn_cvt_pkrtz(u[r][j][0] - (float)h0[0], u[r][j][1] - (float)h0[1]), l1 = __builtin_amdgcn_cvt_pkrtz(u[r][j][2] - (float)h1[0], u[r][j][3] - (float)h1[1]);
                    const int row = 2 * wave + r, off = row * 2048 + ((((lane >> 1) + 32 * j) ^ (row & 15)) << 4) + 8 * (lane & 1);
                    *(LAS v2u*)(lds + R2_UH + off) = (v2u){__builtin_bit_cast(unsigned, h0), __builtin_bit_cast(unsigned, h1)};
                    *(LAS v2u*)(lds + R2_UL + off) = (v2u){__builtin_bit_cast(unsigned, l0), __builtin_bit_cast(unsigned, l1)}; } }
#pragma unroll
            for (int r = 0; r < 2; ++r) store_row_q8(U8 + (size_t)(t0 + r) * D, lane, uq[r]);
            __syncthreads();
            f32x4 acc[2] = {(f32x4){0.f, 0.f, 0.f, 0.f}, (f32x4){0.f, 0.f, 0.f, 0.f}};
#pragma unroll
            for (int s = 0; s < 4; ++s) { const int off = fr * 2048 + (((4 * (4 * wave + s) + fq) ^ fr) << 4);
                const f16x8 ah = *(const LAS f16x8*)(lds + R2_UH + off), al = *(const LAS f16x8*)(lds + R2_UL + off);
#pragma unroll
                for (int nt = 0; nt < 2; ++nt) { acc[nt] = __builtin_amdgcn_mfma_f32_16x16x32_f16(ah, bh[s][nt], acc[nt], 0, 0, 0); acc[nt] = __builtin_amdgcn_mfma_f32_16x16x32_f16(ah, bl[s][nt], acc[nt], 0, 0, 0);
                    acc[nt] = __builtin_amdgcn_mfma_f32_16x16x32_f16(al, bh[s][nt], acc[nt], 0, 0, 0); } }
#pragma unroll
            for (int nt = 0; nt < 2; ++nt)
#pragma unroll
                for (int r = 0; r < 4; ++r) PART[(wave * 16 + 4 * fq + r) * 32 + 16 * nt + fr] = acc[nt][r];
            __syncthreads();
            float sgm = rbias;
#pragma unroll
            for (int w = 0; w < 8; ++w) sgm += PART[(w * 16 + (tid >> 5)) * 32 + (tid & 31)];
            { const int half = lane >> 5, ee = lane & 31; float lg = sgm;
              int si[4]; float sv[4];
#pragma unroll
              for (int k = 0; k < 4; ++k) { float mx = row16_max(lg); mx = fmaxf(mx, __shfl_xor(mx, 16)); const unsigned long long bal = __ballot(lg == mx);
                  const unsigned bits = half ? (unsigned)(bal >> 32) : (unsigned)bal; si[k] = __ffs((int)bits) - 1; sv[k] = mx; if (ee == si[k]) lg = -3.0e38f; }
              const float e1 = ex2((sv[1] - sv[0]) * LOG2E), e2 = ex2((sv[2] - sv[0]) * LOG2E), e3 = ex2((sv[3] - sv[0]) * LOG2E), inv = 1.0f / (1.0f + e1 + e2 + e3);
              if (ee == 0) { const int t = tb + 2 * wave + half;
                  *(LAS v4i*)(lds + R2_TOP + (t - 256 * chunk) * 16) = (v4i){si[0], si[1], si[2], si[3]}; *(LAS f32x4*)(lds + R2_TOP + 4096 + (t - 256 * chunk) * 16) = (f32x4){inv, e1 * inv, e2 * inv, e3 * inv};
#pragma unroll
                  for (int k = 0; k < 4; ++k) __hip_atomic_fetch_add((LAS unsigned*)(MISC + MW_HIST + si[k]), 1u, __ATOMIC_RELAXED, __HIP_MEMORY_SCOPE_WORKGROUP); } }
        }
        __syncthreads();
        if (tid < 256) { *(GAS v4i*)(TOPI + (size_t)(256 * chunk + tid) * 4) = *(const LAS v4i*)(lds + R2_TOP + tid * 16); *(GAS f32x4*)(TOPW + (size_t)(256 * chunk + tid) * 4) = *(const LAS f32x4*)(lds + R2_TOP + 4096 + tid * 16); }
        if (tid < 32) { const unsigned c = MISC[MW_HIST + tid]; WGB[chunk * 32 + tid] = __hip_atomic_fetch_add(etot + tid, c, RLX_AGENT); }
        __syncthreads();
    }
}
__device__ __forceinline__ int build_tiles(const Args& a, volatile LAS unsigned* MISC, int l, int tid) {
    unsigned* etot = (unsigned*)(a.ws + WS_CTL) + CW_ETOT + 64 * l;
    __syncthreads();
    if (tid == 0) { unsigned acc = 0; for (int e = 0; e < NE; ++e) { MISC[MW_EBASE + e] = acc; const unsigned c = __hip_atomic_load(etot + e, RLX_AGENT); MISC[MW_ETOT + e] = c; acc += ((c + 255u) >> 8) << 8; } MISC[MW_EBASE + NE] = acc; }
    __syncthreads();
    const int ntiles = (int)(MISC[MW_EBASE + NE] >> 8);
    volatile LAS unsigned short* te = (volatile LAS unsigned short*)(MISC + MW_TILEE);
    for (int pm = tid; pm < ntiles; pm += 512) { int e = 0; for (int k = 1; k < NE; ++k) if (MISC[MW_EBASE + k] <= (unsigned)pm * 256u) e = k; te[pm] = (unsigned short)e; }
    __syncthreads();
    return ntiles;
}
__device__ __forceinline__ void p_dispatch(const Args& a, LAS unsigned char* lds, volatile LAS unsigned* MISC, int l, int wg, int G, int wave, int lane, int tid) {
    build_tiles(a, MISC, l, tid);
    const int* TOPI = (const int*)(a.ws + WS_TOPI); int* SLOT = (int*)(a.ws + WS_SLOT); const unsigned* WGB = (const unsigned*)(a.ws + WS_WGB); int* ROWMAP = (int*)(a.ws + WS_ROWMAP);
    for (int e = wg; e < NE; e += G) {
        const unsigned lo = MISC[MW_EBASE + e] + MISC[MW_ETOT + e], hi = MISC[MW_EBASE + e + 1];
        for (unsigned s2 = lo + tid; s2 < hi; s2 += 512) ROWMAP[s2] = 0; }
    for (int chunk = wg; chunk < T / 256; chunk += G) {
        if (tid < 32) { MISC[MW_HIST + tid] = 0u; MISC[MW_WGB + tid] = WGB[chunk * 32 + tid]; }
        __syncthreads();
#pragma unroll
        for (int it = 0; it < 2; ++it) { const int p = tid + 512 * it; const int e = TOPI[(size_t)256 * chunk * 4 + p];
            const unsigned r = __hip_atomic_fetch_add((LAS unsigned*)(MISC + MW_HIST + e), 1u, __ATOMIC_RELAXED, __HIP_MEMORY_SCOPE_WORKGROUP);
            const int slot = (int)(MISC[MW_EBASE + e] + MISC[MW_WGB + e] + r); SLOT[(size_t)256 * chunk * 4 + p] = slot; ROWMAP[slot] = 256 * chunk + (p >> 2); }
        __syncthreads();
    }
}
#ifndef PROJ_WGM
#define PROJ_WGM 8
#endif
#ifndef MOE_WGM
#define MOE_WGM 8
#endif
constexpr int R3N = 2;
__device__ __forceinline__ void p_r3(const Args& a, LAS unsigned char* lds, int l, int wg, int G, int wave, int lane, int tid) {
    const float* mods = (const float*)(a.ws + WS_MODS); const bf16* X1 = (const bf16*)(a.ws + WS_X1); const unsigned char* Z = a.ws + WS_XG;
    const int* SLOT = (const int*)(a.ws + WS_SLOT); const float* TOPW = (const float*)(a.ws + WS_TOPW);
    float* xo = a.out; bf16* xbo = (bf16*)(a.ws + WS_X); bf16* U = (bf16*)(a.ws + WS_U);
    const float* l2g = a.in[I_LN2G] + l * D; const float* l2b = a.in[I_LN2B] + l * D;
    LAS f32x4* PV = (LAS f32x4*)lds;
    for (int chunk = wg; chunk < T / 256; chunk += G) {
        const int b = (256 * chunk) / SEQ; const float* mb = mods + ((size_t)l * BATCH + b) * 6 * D; const float* mn = mods + ((size_t)(l + 1 < DEPTH ? l + 1 : l) * BATCH + b) * 6 * D;
        __syncthreads();
        for (int i = tid; i < 5 * 256; i += 512) { const int v = i >> 8, q = i & 255; const float* src = v == 0 ? mb + 5 * D : v == 1 ? l2g : v == 2 ? l2b : v == 3 ? mn + D : mn; PV[i] = *(const GAS f32x4*)(src + 4 * q); }
        __syncthreads();
        const int tw = 256 * chunk + 32 * wave;
        v4i sl[R3N]; f32x4 wt[R3N];
#pragma unroll
        for (int r = 0; r < R3N; ++r) { sl[r] = *(const GAS v4i*)(SLOT + (size_t)(tw + r) * 4); wt[r] = *(const GAS f32x4*)(TOPW + (size_t)(tw + r) * 4); }
        for (int i = 0; i < 32; i += R3N) {
            const int t0 = tw + i;
            f32x4 f[R3N][4], x[R3N][4]; unsigned z[R3N][4][4]; v2u zraw[R3N][4][2]; RowRaw xraw[R3N];
            const bool oddl = (lane & 1) != 0; const int zoff = 4 * (lane & ~1) + (oddl ? 256 : 0);
#pragma unroll
            for (int r = 0; r < R3N; ++r)
#pragma unroll
                for (int k = 0; k < 4; ++k) { const unsigned char* zr = Z + (size_t)sl[r][k] * D + zoff; zraw[r][k][0] = *(const GAS v2u*)zr; zraw[r][k][1] = *(const GAS v2u*)(zr + 512); }
#pragma unroll
            for (int r = 0; r < R3N; ++r) load_row_raw(X1 + (size_t)(t0 + r) * D, lane, xraw[r]);
            f32x4 wcur[R3N];
#pragma unroll
            for (int r = 0; r < R3N; ++r) wcur[r] = wt[r];
            if (i + R3N < 32) {
#pragma unroll
                for (int r = 0; r < R3N; ++r) { sl[r] = *(const GAS v4i*)(SLOT + (size_t)(t0 + R3N + r) * 4); wt[r] = *(const GAS f32x4*)(TOPW + (size_t)(t0 + R3N + r) * 4); } }
#pragma unroll
            for (int r = 0; r < R3N; ++r) {
#pragma unroll
                for (int k = 0; k < 4; ++k)
#pragma unroll
                    for (int pr = 0; pr < 2; ++pr) { const unsigned lo = zraw[r][k][pr].x, hi = zraw[r][k][pr].y, recv = dpp_swap1(oddl ? lo : hi); z[r][k][2 * pr] = oddl ? recv : lo; z[r][k][2 * pr + 1] = oddl ? hi : recv; }
                v2u xw[4]; unpack_row_raw(xraw[r], lane, xw);
#pragma unroll
                for (int j = 0; j < 4; ++j) x[r][j] = (f32x4){bf_lo(xw[j].x), bf_hi(xw[j].x), bf_lo(xw[j].y), bf_hi(xw[j].y)}; }
#pragma unroll
            for (int r = 0; r < R3N; ++r)
#pragma unroll
                for (int j = 0; j < 4; ++j) { f[r][j] = (f32x4){0.f, 0.f, 0.f, 0.f};
#pragma unroll
                    for (int k = 0; k < 4; ++k) { const int w = (int)z[r][k][j]; const f32x2 lo = __builtin_amdgcn_cvt_pk_f32_fp8(w, false), hi = __builtin_amdgcn_cvt_pk_f32_fp8(w, true);
                        f[r][j] += (wcur[r][k] * (1.0f / F8_SZ)) * (f32x4){lo[0], lo[1], hi[0], hi[1]}; } }
#pragma unroll
            for (int j = 0; j < 4; ++j) { const f32x4 g2 = PV[0 * 256 + lane + 64 * j];
#pragma unroll
                for (int r = 0; r < R3N; ++r) x[r][j] = ALPHA * x[r][j] + (1.0f + g2) * f[r][j]; }
            float mean[R3N], rstd[R3N]; v2u ob[R3N][4];
#pragma unroll
            for (int r = 0; r < R3N; ++r) ln_stats(x[r], mean[r], rstd[r]);
#pragma unroll
            for (int j = 0; j < 4; ++j) { const f32x4 g = PV[1 * 256 + lane + 64 * j], bb = PV[2 * 256 + lane + 64 * j];
#pragma unroll
                for (int r = 0; r < R3N; ++r) { x[r][j] = (x[r][j] - mean[r]) * rstd[r] * g + bb;
                    if (l == DEPTH - 1) *(GAS f32x4*)(xo + (size_t)(t0 + r) * D + 4 * lane + 256 * j) = x[r][j];
                    else { ob[r][j].x = pk2(x[r][j][0], x[r][j][1]); ob[r][j].y = pk2(x[r][j][2], x[r][j][3]); } } }
            if (l != DEPTH - 1) {
#pragma unroll
                for (int r = 0; r < R3N; ++r) store_row_pk(xbo + (size_t)(t0 + r) * D, lane, ob[r]); }
            if (l + 1 < DEPTH) {
#pragma unroll
                for (int r = 0; r < R3N; ++r) ln_stats(x[r], mean[r], rstd[r]);
#pragma unroll
                for (int j = 0; j < 4; ++j) { const f32x4 s1 = PV[3 * 256 + lane + 64 * j], s0 = PV[4 * 256 + lane + 64 * j];
#pragma unroll
                    for (int r = 0; r < R3N; ++r) { const f32x4 u = (x[r][j] - mean[r]) * rstd[r] * (1.0f + s1) + s0; ob[r][j].x = pk2(u[0], u[1]); ob[r][j].y = pk2(u[2], u[3]); } }
#pragma unroll
                for (int r = 0; r < R3N; ++r) store_row_pk(U + (size_t)(t0 + r) * D, lane, ob[r]); }
        }
    }
}

__global__ void __launch_bounds__(512, 2) fwd(Args a) {
    extern __shared__ __attribute__((aligned(16))) unsigned char lds_raw[];
    LAS unsigned char* lds = (LAS unsigned char*)lds_raw;
    volatile LAS unsigned* MISC = (volatile LAS unsigned*)(lds + MISC_OFF);
    const int tid = threadIdx.x, lane = tid & 63, wave = __builtin_amdgcn_readfirstlane(tid >> 6), G = gridDim.x, wg = blockIdx.x;
    const int wave_s = wave;
    const int gw = wg * 8 + wave, NGW = G * 8;
    unsigned* ctl = (unsigned*)(a.ws + WS_CTL);
    for (int u = tid; u < (LDS_BYTES - MISC_OFF) / 4; u += 512) MISC[u] = 0u;
    __syncthreads();
#if MK_ONE_LAUNCH
    XcdBarrier bar = xcd_barrier_post(ctl + CW_BAR, MISC);
#define GRID_BAR() xcd_barrier(bar)
#else
#define GRID_BAR() do { } while (0)
#endif
    const int lo = a.ph_lo, hi = a.ph_hi;
#define IN(k) (lo <= (k) && (k) < hi)
static_assert(CVT_TICKETS_L * 3 == BATCH * NH * 6, "conversion tickets interleave 1 : 3 with the attention tickets");
static_assert(pg8::BIAS_LDS_OFF == MISC_OFF + 4096 && pg8::BIAS_LDS_OFF + 2048 <= LDS_BYTES, "bias staging area inside the LDS control region");
#define BOTH(k) (IN(k) && IN((k) + 1))
#ifndef ONLY_PHASE
#define ONLY_PHASE -1
#endif
#define PH_ON(k) (ONLY_PHASE < 0 || ONLY_PHASE == (k))
    if (PH_ON(100) && IN(0)) { p0_mods(a, lds, wg, G, wave, lane, tid);
        p0_convert(a, lds, gw, NGW, wave, lane); if (BOTH(0)) GRID_BAR(); }
    if (PH_ON(101) && IN(1)) { p_r0(a, gw, NGW, lane); if (BOTH(1)) GRID_BAR(); }
#pragma unroll 1
    for (int l = 0; l < DEPTH; ++l) {
        const int g0 = 2 + NPH_LAYER * l;
#define OPAQUE_TID() unsigned tid_z = 0u; asm volatile("" : "+v"(tid_z)); int tid = wave_s * 64 + (int)__builtin_amdgcn_mbcnt_hi(~0u, __builtin_amdgcn_mbcnt_lo(~0u, tid_z)); asm volatile("" : "+v"(tid)); const int lane = tid & 63; const int wave = __builtin_amdgcn_readfirstlane(tid >> 6); const int gw = wg * 8 + wave; (void)lane; (void)gw
        if (PH_ON(0) && IN(g0 + 0)) { OPAQUE_TID();
            pg8::Gemm g{(const bf16*)(a.ws + WS_U), (const bf16*)(a.ws + WS_WIN) + (size_t)l * NIN * D, D, 0, nullptr};
            pg8::TileOrder S; S.init(T / 256, NIN / 256, G, wg, nullptr, PROJ_WGM);
            pg8::EpiBf16 E{(bf16*)(a.ws + WS_QKV), NIN, nullptr, 0, 1.0f};
            pg8::gemm_phase<pg8::EpiBf16, pg8::TileOrder, true, true>(lds, g, S, E, tid);
            if (BOTH(g0 + 0)) GRID_BAR();
        }
        if (PH_ON(1) && IN(g0 + 1)) { OPAQUE_TID();
            unsigned* qctr = ctl + CW_QCTR + 64 * l;
            constexpr int NLRU = 128, NATT = BATCH * NH * 6;
            constexpr int ncvt = CVT_TICKETS_L, NTK = NLRU + ncvt + NATT;
            int nxt = -1;
            for (;;) {
                if (tid == 0) { int t = nxt; if (t < 0) t = (int)__hip_atomic_fetch_add(qctr, 1u, RLX_AGENT); MISC[MW_TICKET] = (unsigned)t; }
                __syncthreads();
                const int tk = (int)MISC[MW_TICKET];
                __syncthreads();
                if (tk >= NTK) break;
                nxt = -1;
                unsigned tz = 0u; asm volatile("" : "+v"(tz)); const int lane_t = (int)__builtin_amdgcn_mbcnt_hi(~0u, __builtin_amdgcn_mbcnt_lo(~0u, tz)), tid_t = wave_s * 64 + lane_t; int wave_t = wave_s; asm volatile("" : "+s"(wave_t));
                if (tk < NLRU) lru::unit(lds, a, l, tk, wave_t, lane_t, tid_t);
                else { const int tp = tk - NLRU, g4 = tp >> 2;
                    if ((tp & 3) == 0) cvt_ticket(a, lds, l, g4, wave_t, lane_t); else nxt = att::ticket(lds, a, tp - g4 - 1, wave_t, lane_t, qctr); }
            }
            if (BOTH(g0 + 1)) GRID_BAR();
        }
        if (PH_ON(2) && IN(g0 + 2)) { OPAQUE_TID(); p_merge(a, l, gw, NGW, lane); if (BOTH(g0 + 2)) GRID_BAR(); }
        if (PH_ON(3) && IN(g0 + 3)) { OPAQUE_TID();
            pg8::Gemm g{(const bf16*)(a.ws + WS_U), (const bf16*)(a.ws + WS_WOUT) + (size_t)l * D * D, D, 0, nullptr};
            pg8::TileOrder S; S.init(T / 256, D / 256, G, wg, nullptr, PROJ_WGM);
            pg8::EpiBf16 E{(bf16*)(a.ws + WS_MIX), D, nullptr, 0, 1.0f};
            pg8::gemm_phase<pg8::EpiBf16, pg8::TileOrder, true, true>(lds, g, S, E, tid);
            if (BOTH(g0 + 3)) GRID_BAR();
        }
        if (PH_ON(4) && IN(g0 + 4)) { OPAQUE_TID(); p_r2(a, lds, MISC, l, wg, G, wave, lane, tid); if (BOTH(g0 + 4)) GRID_BAR(); }
        if (PH_ON(5) && IN(g0 + 5)) { OPAQUE_TID(); p_dispatch(a, lds, MISC, l, wg, G, wave, lane, tid); if (BOTH(g0 + 5)) GRID_BAR(); }
        if (PH_ON(6) && IN(g0 + 6)) { OPAQUE_TID();
            const int ntiles = build_tiles(a, MISC, l, tid);
            pg8::Gemm g{(const bf16*)(a.ws + WS_U8), (const bf16*)(a.ws + WS_W1 + (size_t)l * NE * 2 * DFF * D), D / 2, (size_t)2 * DFF * D, (const int*)(a.ws + WS_ROWMAP)};
            pg8::TileOrder S; S.init(ntiles, 8, G, wg, (const LAS unsigned short*)(MISC + MW_TILEE), MOE_WGM);
            pg8::EpiSwiglu8 E{a.ws + WS_ACT, a.in[I_B1] + (size_t)l * NE * 2 * DFF, 1.0f / (F8_SA1 * F8_SW), F8_SA2};
            pg8::gemm_phase<pg8::EpiSwiglu8, pg8::TileOrder, true, true, true, true>(lds, g, S, E, tid);
            if (BOTH(g0 + 6)) GRID_BAR();
        }
        if (PH_ON(7) && IN(g0 + 7)) { OPAQUE_TID();
            const int ntiles = build_tiles(a, MISC, l, tid);
            pg8::Gemm g{(const bf16*)(a.ws + WS_ACT), (const bf16*)(a.ws + WS_W2 + (size_t)l * NE * D * DFF), DFF / 2, (size_t)D * DFF, nullptr};
            pg8::TileOrder S; S.init(ntiles, 4, G, wg, (const LAS unsigned short*)(MISC + MW_TILEE), MOE_WGM);
            pg8::EpiFp8 E{a.ws + WS_XG, D, a.in[I_B2] + (size_t)l * NE * D, D, 1.0f / (F8_SA2 * F8_SW), F8_SZ};
            pg8::gemm_phase<pg8::EpiFp8, pg8::TileOrder, true, true, true>(lds, g, S, E, tid);
            if (BOTH(g0 + 7)) GRID_BAR();
        }
        if (PH_ON(8) && IN(g0 + 8)) { OPAQUE_TID(); p_r3(a, lds, l, wg, G, wave, lane, tid); if (BOTH(g0 + 8)) GRID_BAR(); }
    }
}

extern "C" void kernel_launch(void* const* d_in, const int* in_sizes, int n_in, void* d_out, int out_size, void* d_ws, size_t ws_size, hipStream_t stream) {
    static int grid = 0;
    if (grid == 0) {
        if (n_in != 25 || out_size != T * D || ws_size < WS_END) { fprintf(stderr, "kernel_launch: unexpected shapes (n_in %d out %d ws %zu)\n", n_in, out_size, ws_size); grid = -1; return; }
        int dev = 0, cus = 0, per_cu = 0;
        if (hipGetDevice(&dev) != hipSuccess || hipDeviceGetAttribute(&cus, hipDeviceAttributeMultiprocessorCount, dev) != hipSuccess) { grid = -1; return; }
        if (hipFuncSetAttribute((const void*)fwd, hipFuncAttributeMaxDynamicSharedMemorySize, LDS_BYTES) != hipSuccess) { fprintf(stderr, "kernel_launch: hipFuncSetAttribute failed\n"); grid = -1; return; }
        if (hipOccupancyMaxActiveBlocksPerMultiprocessor(&per_cu, (const void*)fwd, 512, LDS_BYTES) != hipSuccess || per_cu < 1) fprintf(stderr, "kernel_launch: occupancy query reports %d\n", per_cu);
        (void)hipGetLastError();
        grid = cus;
    }
    if (grid < 0) return;
    (void)hipMemsetAsync((char*)d_ws + WS_CTL, 0, CTL_ZERO_BYTES, stream);
    Args a{};
    for (int i = 0; i < 25; ++i) a.in[i] = (const float*)d_in[i];
    a.out = (float*)d_out; a.ws = (unsigned char*)d_ws;
#if MK_ONE_LAUNCH
    a.ph_lo = 0; a.ph_hi = NPH;
    hipLaunchKernelGGL(fwd, dim3(grid), dim3(512), LDS_BYTES, stream, a);
#else
    for (int p = 0; p < NPH; ++p) { a.ph_lo = p; a.ph_hi = p + 1; hipLaunchKernelGGL(fwd, dim3(grid), dim3(512), LDS_BYTES, stream, a); }
#endif
}
```
